# Optimizing an MI355X kernel written in HIP

```python
import jax, jax.numpy as jnp
from jax import lax
import numpy as np

D_MODEL = 1024
BATCH = 2
SEQ = 16384
DEPTH = 2

CHUNK = 64
N_MEM = 256
HEAD_DIM = 64
FOX_HEADS = 8
CHUNK_HEADS = 8
FOX_WIDTH = FOX_HEADS * HEAD_DIM
CHUNK_WIDTH = CHUNK_HEADS * HEAD_DIM
IN_COLS = 3 * FOX_WIDTH + FOX_HEADS + 3 * CHUNK_WIDTH
Q_BLOCK = 128
LEFT_CHUNKS = 8
REL_CLIP = 128
NUM_REL = CHUNK + REL_CLIP
MEM_HEADS = 4
MEM_HEAD_DIM = D_MODEL // MEM_HEADS
D_FF = -(-8 * D_MODEL // 768) * 256
EPS = 1e-6
NEG_INF = -1e30

kernel_name = "hybrid_fox_chunkrel_memxattn_block"


def rms_norm(x, g):
    xf = x.astype(jnp.float32)
    y = xf * lax.rsqrt(jnp.mean(xf * xf, axis=-1, keepdims=True) + EPS)
    return (y * g.astype(jnp.float32)).astype(x.dtype)


def fox_attention(q, k, v, log_f):
    B, S, H, D = q.shape
    nb = S // Q_BLOCK
    scale = D ** -0.5
    c = lax.cumsum(log_f, axis=1)
    c_keys = jnp.transpose(c, (0, 2, 1))
    k_pos = jnp.arange(S)
    q_blocks = jnp.transpose(q.reshape(B, nb, Q_BLOCK, H, D), (1, 0, 2, 3, 4))
    c_blocks = jnp.transpose(c.reshape(B, nb, Q_BLOCK, H), (1, 0, 3, 2))

    def one_block(args):
        i, q_i, c_i = args
        q_pos = i * Q_BLOCK + jnp.arange(Q_BLOCK)
        s = jnp.einsum('bqhd,bkhd->bhqk', q_i, k).astype(jnp.float32) * scale
        s = s + c_i[..., :, None] - c_keys[:, :, None, :]
        s = jnp.where((k_pos[None, :] <= q_pos[:, None])[None, None], s, NEG_INF)
        p = jax.nn.softmax(s, axis=-1)
        return jnp.einsum('bhqk,bkhd->bqhd', p.astype(v.dtype), v)

    out = lax.map(one_block, (jnp.arange(nb), q_blocks, c_blocks))
    return jnp.transpose(out, (1, 0, 2, 3, 4)).reshape(B, S, H, D)


def chunked_rel_attention(q, k, v, rel_bias):
    B, S, H, D = q.shape
    nc = S // CHUNK
    band = (LEFT_CHUNKS + 1) * CHUNK
    pad = LEFT_CHUNKS * CHUNK
    scale = D ** -0.5
    kp = jnp.pad(k, ((0, 0), (pad, 0), (0, 0), (0, 0)))
    vp = jnp.pad(v, ((0, 0), (pad, 0), (0, 0), (0, 0)))
    idx = (jnp.arange(nc) * CHUNK)[:, None] + jnp.arange(band)[None, :]
    k_band = kp[:, idx]
    v_band = vp[:, idx]
    q_c = q.reshape(B, nc, CHUNK, H, D)
    s = jnp.einsum('bnqhd,bnkhd->bhnqk', q_c, k_band).astype(jnp.float32) * scale
    dist = jnp.arange(CHUNK)[:, None] + pad - jnp.arange(band)[None, :]
    rel_idx = jnp.clip(dist, -(CHUNK - 1), REL_CLIP) + (CHUNK - 1)
    bias = rel_bias.astype(jnp.float32)[:, rel_idx]
    s = s + bias[None, :, None]
    valid = (idx - pad) >= 0
    s = jnp.where(valid[None, None, :, None, :], s, NEG_INF)
    p = jax.nn.softmax(s, axis=-1)
    o = jnp.einsum('bhnqk,bnkhd->bnqhd', p.astype(v.dtype), v_band)
    return o.reshape(B, S, H, D)


def memory_cross_attention(h, m, w_q, w_kv, w_o):
    B, S, _ = h.shape
    q = (h @ w_q).reshape(B, S, MEM_HEADS, MEM_HEAD_DIM)
    k, v = jnp.split(m @ w_kv, 2, axis=-1)
    k = k.reshape(B, N_MEM, MEM_HEADS, MEM_HEAD_DIM)
    v = v.reshape(B, N_MEM, MEM_HEADS, MEM_HEAD_DIM)
    s = jnp.einsum('bshd,bmhd->bhsm', q, k).astype(jnp.float32) * (MEM_HEAD_DIM ** -0.5)
    p = jax.nn.softmax(s, axis=-1)
    o = jnp.einsum('bhsm,bmhd->bshd', p.astype(v.dtype), v).reshape(B, S, D_MODEL)
    return o @ w_o


def swiglu(h, w_gate_up, w_down):
    g, u = jnp.split(h @ w_gate_up, 2, axis=-1)
    return (jax.nn.silu(g) * u) @ w_down


def setup_inputs(seed: int = 0) -> dict:
    key = jax.random.key(seed)
    ks = jax.random.split(key, 24)

    def nrm(k, shape, scale):
        return scale * jax.random.normal(k, shape, jnp.float32)

    def gain(k, n):
        return 1.0 + nrm(k, (DEPTH, n), 0.05)

    s_d = D_MODEL ** -0.5
    w_in = jnp.concatenate([
        nrm(ks[0], (DEPTH, D_MODEL, 3 * FOX_WIDTH), s_d),
        nrm(ks[1], (DEPTH, D_MODEL, FOX_HEADS), 0.1 * s_d),
        nrm(ks[2], (DEPTH, D_MODEL, 3 * CHUNK_WIDTH), s_d),
    ], axis=-1)
    b_fgate = jnp.linspace(3.0, 7.0, FOX_HEADS)[None, :] + nrm(ks[3], (DEPTH, FOX_HEADS), 0.3)
    return {
        "x": jax.random.normal(ks[4], (BATCH, SEQ, D_MODEL), jnp.float32),
        "mem": jax.random.normal(ks[5], (BATCH, N_MEM, D_MODEL), jnp.float32),
        "g_mix_pre": gain(ks[6], D_MODEL),
        "w_in": w_in,
        "b_fgate": b_fgate,
        "rel_bias": nrm(ks[7], (DEPTH, CHUNK_HEADS, NUM_REL), 0.5),
        "g_fox_out": gain(ks[8], FOX_WIDTH),
        "g_chunk_out": gain(ks[9], CHUNK_WIDTH),
        "w_out": nrm(ks[10], (DEPTH, D_MODEL, D_MODEL), s_d),
        "g_mix_post": gain(ks[11], D_MODEL),
        "g_mem_pre": gain(ks[12], D_MODEL),
        "g_mem_kv": gain(ks[13], D_MODEL),
        "w_mem_q": nrm(ks[14], (DEPTH, D_MODEL, D_MODEL), s_d),
        "w_mem_kv": nrm(ks[15], (DEPTH, D_MODEL, 2 * D_MODEL), s_d),
        "w_mem_o": nrm(ks[16], (DEPTH, D_MODEL, D_MODEL), s_d),
        "g_mem_post": gain(ks[17], D_MODEL),
        "g_ffn_pre": gain(ks[18], D_MODEL),
        "w_gate_up": nrm(ks[19], (DEPTH, D_MODEL, 2 * D_FF), s_d),
        "w_down": nrm(ks[20], (DEPTH, D_FF, D_MODEL), D_FF ** -0.5),
        "g_ffn_post": gain(ks[21], D_MODEL),
    }


def reference(x, mem, g_mix_pre, w_in, b_fgate, rel_bias, g_fox_out, g_chunk_out, w_out,
              g_mix_post, g_mem_pre, g_mem_kv, w_mem_q, w_mem_kv, w_mem_o, g_mem_post,
              g_ffn_pre, w_gate_up, w_down, g_ffn_post):
    B, S, _ = x.shape
    splits = [FOX_WIDTH, 2 * FOX_WIDTH, 3 * FOX_WIDTH, 3 * FOX_WIDTH + FOX_HEADS,
              3 * FOX_WIDTH + FOX_HEADS + CHUNK_WIDTH, 3 * FOX_WIDTH + FOX_HEADS + 2 * CHUNK_WIDTH]
    for l in range(DEPTH):
        h = rms_norm(x, g_mix_pre[l])
        proj = h @ w_in[l]
        q_f, k_f, v_f, f_logit, q_c, k_c, v_c = jnp.split(proj, splits, axis=-1)
        log_f = jax.nn.log_sigmoid((f_logit + b_fgate[l]).astype(jnp.float32))
        o_f = fox_attention(q_f.reshape(B, S, FOX_HEADS, HEAD_DIM),
                            k_f.reshape(B, S, FOX_HEADS, HEAD_DIM),
                            v_f.reshape(B, S, FOX_HEADS, HEAD_DIM), log_f)
        o_c = chunked_rel_attention(q_c.reshape(B, S, CHUNK_HEADS, HEAD_DIM),
                                    k_c.reshape(B, S, CHUNK_HEADS, HEAD_DIM),
                                    v_c.reshape(B, S, CHUNK_HEADS, HEAD_DIM), rel_bias[l])
        o_f = rms_norm(o_f.reshape(B, S, FOX_WIDTH), g_fox_out[l])
        o_c = rms_norm(o_c.reshape(B, S, CHUNK_WIDTH), g_chunk_out[l])
        mix = jnp.concatenate([o_f, o_c], axis=-1) @ w_out[l]
        x = x + rms_norm(mix, g_mix_post[l])
        h = rms_norm(x, g_mem_pre[l])
        m = rms_norm(mem, g_mem_kv[l])
        ca = memory_cross_attention(h, m, w_mem_q[l], w_mem_kv[l], w_mem_o[l])
        x = x + rms_norm(ca, g_mem_post[l])
        h = rms_norm(x, g_ffn_pre[l])
        x = x + rms_norm(swiglu(h, w_gate_up[l], w_down[l]), g_ffn_post[l])
    return x
```

```cpp
#include <hip/hip_runtime.h>
#include <hip/hip_cooperative_groups.h>
#include <hip/hip_bf16.h>
#include <cstdio>
#include <cstdint>
#include <cmath>
namespace cg = cooperative_groups;
namespace pg8 {
#define PG8_LAS __attribute__((address_space(3)))
typedef unsigned short bf16_t;
typedef short bf16x8 __attribute__((ext_vector_type(8)));
typedef float f32x4 __attribute__((ext_vector_type(4)));
typedef unsigned u32x4 __attribute__((ext_vector_type(4)));
constexpr int BM = 256, BK = 64, HALF = 128, HTB = HALF * BK * 2  , STAGE_BYTES = 8 * HTB, NXCD = 8, WGM = 8;

__host__ __device__ __forceinline__ int lds_byte(int r, int c) { const int st = (r >> 4) * 2 + (c >> 5), rr = r & 15, cc = c & 31, ob = rr * 64 + cc * 2; return st * 1024 + (ob ^ (((ob >> 9) & 1) << 5)); }
__host__ __device__ __forceinline__ void stage_rc(int b, int& R, int& C) { const int st = b / 1024, sb = b % 1024, swz = sb ^ (((sb >> 9) & 1) << 5); R = (st >> 1) * 16 + swz / 64; C = (st & 1) * 32 + (swz % 64) / 2; }
__host__ __device__ __forceinline__ int perm32(int rho) { const int n = rho >> 4, i = rho & 15; return 8 * (i >> 2) + 4 * n + (i & 3); }

__device__ __forceinline__ void glds16s(const void* sbase, unsigned voff, unsigned lds_dst) {
    asm volatile("s_mov_b32 m0, %2\n\ts_nop 0\n\tglobal_load_lds_dwordx4 %0, %1" : : "v"(voff), "s"(sbase), "s"(lds_dst) : "memory"); }
struct Unit { int pm, pn; size_t ao, bo; };
struct Gemm { const bf16_t* A; const bf16_t* Bt; int K, lda, ldb; };

struct Order {
    int nM, nN, nwg, G, c, bdiv; size_t a_pm, a_pn, b_pn, b_pb;
    __device__ __forceinline__ void init(int nM_, int nN_, int G_, int c_, size_t a_pm_, size_t a_pn_, size_t b_pn_, size_t b_pb_, int bdiv_) {
        nM = nM_; nN = nN_; nwg = nM_ * nN_; G = G_; c = c_; a_pm = a_pm_; a_pn = a_pn_; b_pn = b_pn_; b_pb = b_pb_; bdiv = bdiv_; }
    __device__ __forceinline__ bool next(int i, Unit& u) const {
        const long L = (long)i * G + c; if (L >= nwg) return false;
        int wgid = (int)L; { const int q = nwg / NXCD, r = nwg % NXCD, xcd = wgid % NXCD, off = wgid / NXCD; wgid = (xcd < r ? xcd * (q + 1) : r * (q + 1) + (xcd - r) * q) + off; }
        const int nig = WGM * nN, gid = wgid / nig, fm = gid * WGM, gsz = (nM - fm) < WGM ? (nM - fm) : WGM;
        u.pm = fm + ((wgid % nig) % gsz); u.pn = (wgid % nig) / gsz;
        u.ao = (size_t)u.pm * a_pm + (size_t)u.pn * a_pn; u.bo = (size_t)u.pn * b_pn + (size_t)(u.pm / bdiv) * b_pb; return true;
    }
    __device__ __forceinline__ void a_ready(const Unit&) const {}
    __device__ __forceinline__ void done(const Unit&) const {}
};
__device__ __forceinline__ unsigned cvt_pk_bf16(float lo, float hi) { unsigned r; asm volatile("v_cvt_pk_bf16_f32 %0, %1, %2" : "=v"(r) : "v"(lo), "v"(hi)); return r; }
typedef float f32x2 __attribute__((ext_vector_type(2)));
template <int MASK> __device__ __forceinline__ float swz_xor(float v) { return __builtin_bit_cast(float, __builtin_amdgcn_ds_swizzle(__builtin_bit_cast(int, v), (MASK << 10) | 0x1f)); }
__device__ __forceinline__ void half_swap(float& a, float& b) { asm volatile("s_nop 1\n\tv_permlane32_swap_b32_e32 %0, %1\n\ts_nop 1" : "+v"(a), "+v"(b)); }
__device__ __forceinline__ float half_sum(float v) { float a = v, b = v; half_swap(a, b); return a + b; }
__device__ __forceinline__ float half_max(float v) { float a = v, b = v; half_swap(a, b); return fmaxf(a, b); }

struct EpiStore {
    static constexpr bool PERM = true, AFTER_DRAIN = false;
    bf16_t* O; int ldc; const float* stat;
    __device__ __forceinline__ static float rstd512(float s) { return 1.0f / sqrtf(s * (1.0f / 512.0f) + 1e-6f); }
    __device__ __forceinline__ void mid(f32x4 (&acc)[2][2][4][2], const Unit& u, int wr) const {
        int l_ = threadIdx.x; asm volatile("" : "+v"(l_)); const int fr = l_ & 15;
#pragma unroll
        for (int ai = 0; ai < 2; ++ai)
#pragma unroll
            for (int m = 0; m < 4; ++m) { const f32x2 sv = *(const f32x2*)(stat + (size_t)(u.pm * BM + wr * 64 + fr + ai * HALF + m * 16) * 2); const float f = rstd512(sv[0]) / rstd512(sv[1]);
#pragma unroll
                for (int bj = 0; bj < 2; ++bj) { acc[ai][bj][m][0] = acc[ai][bj][m][0] * f; acc[ai][bj][m][1] = acc[ai][bj][m][1] * f; } }
    }
    __device__ __forceinline__ void operator()(const f32x4 (&acc)[2][2][4][2], const Unit& u, int wr, int wc, int fr_, int fq_) const {
        int l_ = threadIdx.x; asm volatile("" : "+v"(l_)); const int fr = l_ & 15, fq = (l_ >> 4) & 3; (void)fr_; (void)fq_;
        const int row0 = u.pm * BM + wr * 64 + fr, col0 = u.pn * BM + wc * 32 + 8 * fq;
#pragma unroll
        for (int ai = 0; ai < 2; ++ai)
#pragma unroll
            for (int m = 0; m < 4; ++m) { bf16_t* rowp = O + (size_t)(row0 + ai * HALF + m * 16) * ldc + col0;
                float rs = 1.0f; if (stat) rs = rstd512(stat[(size_t)(row0 + ai * HALF + m * 16) * 2 + 1]);
#pragma unroll
                for (int bj = 0; bj < 2; ++bj) { const f32x4 v0 = acc[ai][bj][m][0] * rs, v1 = acc[ai][bj][m][1] * rs;
                    u32x4 w; w.x = cvt_pk_bf16(v0[0], v0[1]); w.y = cvt_pk_bf16(v0[2], v0[3]); w.z = cvt_pk_bf16(v1[0], v1[1]); w.w = cvt_pk_bf16(v1[2], v1[3]);
                    *(u32x4*)(rowp + bj * HALF) = w; } }
    }
};
struct EpiSwiglu {
    static constexpr bool PERM = true, AFTER_DRAIN = false; static constexpr const float* stat = nullptr;
    __device__ __forceinline__ void mid(f32x4 (&)[2][2][4][2], const Unit&, int) const {}
    bf16_t* O; int ldc;
    __device__ __forceinline__ static float silu_mul(float g, float u) { return g * __builtin_amdgcn_rcpf(1.0f + __builtin_amdgcn_exp2f(-1.4426950408889634f * g)) * u; }
    __device__ __forceinline__ void operator()(const f32x4 (&acc)[2][2][4][2], const Unit& u, int wr, int wc, int fr_, int fq_) const {
        int l_ = threadIdx.x; asm volatile("" : "+v"(l_)); const int fr = l_ & 15, fq = (l_ >> 4) & 3; (void)fr_; (void)fq_;
        const int row0 = u.pm * BM + wr * 64 + fr, col0 = u.pn * HALF + wc * 32 + 8 * fq;
#pragma unroll
        for (int ai = 0; ai < 2; ++ai)
#pragma unroll
            for (int m = 0; m < 4; ++m) { bf16_t* rowp = O + (size_t)(row0 + ai * HALF + m * 16) * ldc + col0;
                const f32x4 g0 = acc[ai][0][m][0], g1 = acc[ai][0][m][1], u0 = acc[ai][1][m][0], u1 = acc[ai][1][m][1];
                u32x4 w; w.x = cvt_pk_bf16(silu_mul(g0[0], u0[0]), silu_mul(g0[1], u0[1])); w.y = cvt_pk_bf16(silu_mul(g0[2], u0[2]), silu_mul(g0[3], u0[3]));
                w.z = cvt_pk_bf16(silu_mul(g1[0], u1[0]), silu_mul(g1[1], u1[1])); w.w = cvt_pk_bf16(silu_mul(g1[2], u1[2]), silu_mul(g1[3], u1[3]));
                *(u32x4*)rowp = w; }
    }
};
struct EpiSoftmax {
    static constexpr bool PERM = true, AFTER_DRAIN = false; static constexpr const float* stat = nullptr;
    __device__ __forceinline__ void mid(f32x4 (&)[2][2][4][2], const Unit&, int) const {}
    bf16_t* O; int ldc; PG8_LAS float* X;
    __device__ __forceinline__ void operator()(f32x4 (&acc)[2][2][4][2], const Unit& u, int wr, int wc, int fr_, int fq_) const {
        int l_ = threadIdx.x; asm volatile("" : "+v"(l_)); const int fr = l_ & 15, fq = (l_ >> 4) & 3; (void)fr_; (void)fq_;
        float mx[2][4];
        int xw = ((wr * 64 + fr) * 4 + wc) * 2, xr = (wr * 64 + fr) * 8; asm volatile("" : "+v"(xw), "+v"(xr));
#pragma unroll
        for (int ai = 0; ai < 2; ++ai)
#pragma unroll
            for (int m = 0; m < 4; ++m) {
                float mm = -3.0e38f;
#pragma unroll
                for (int bj = 0; bj < 2; ++bj)
#pragma unroll
                    for (int n = 0; n < 2; ++n) { const f32x4 v = acc[ai][bj][m][n]; mm = fmaxf(mm, fmaxf(fmaxf(v[0], v[1]), fmaxf(v[2], v[3]))); }
                mm = fmaxf(mm, swz_xor<16>(mm)); mm = half_max(mm);
                float s = 0.f;
#pragma unroll
                for (int bj = 0; bj < 2; ++bj)
#pragma unroll
                    for (int n = 0; n < 2; ++n) { f32x4 v = acc[ai][bj][m][n];
                        v[0] = __builtin_amdgcn_exp2f(v[0] - mm); v[1] = __builtin_amdgcn_exp2f(v[1] - mm); v[2] = __builtin_amdgcn_exp2f(v[2] - mm); v[3] = __builtin_amdgcn_exp2f(v[3] - mm);
                        s += (v[0] + v[1]) + (v[2] + v[3]); acc[ai][bj][m][n] = v; }
                s += swz_xor<16>(s); s = half_sum(s);
                mx[ai][m] = mm;
                if (fq == 0) { PG8_LAS float* xp = X + xw + (ai * HALF + m * 16) * 8; xp[0] = mm; xp[1] = s; }
                asm volatile("" ::: "memory"); __builtin_amdgcn_sched_barrier(0);
            }
        asm volatile("s_waitcnt lgkmcnt(0)" ::: "memory"); __builtin_amdgcn_s_barrier(); asm volatile("" ::: "memory");
        const int row0 = u.pm * BM + wr * 64 + fr, col0 = u.pn * BM + wc * 32 + 8 * fq;
#pragma unroll
        for (int ai = 0; ai < 2; ++ai)
#pragma unroll
            for (int m = 0; m < 4; ++m) {
                const f32x4 x0 = *(const PG8_LAS f32x4*)(X + xr + (ai * HALF + m * 16) * 8), x1 = *(const PG8_LAS f32x4*)(X + xr + (ai * HALF + m * 16) * 8 + 4);
                const float M = fmaxf(fmaxf(x0[0], x0[2]), fmaxf(x1[0], x1[2]));
                const float L = x0[1] * __builtin_amdgcn_exp2f(x0[0] - M) + x0[3] * __builtin_amdgcn_exp2f(x0[2] - M) + x1[1] * __builtin_amdgcn_exp2f(x1[0] - M) + x1[3] * __builtin_amdgcn_exp2f(x1[2] - M);
                const float f = __builtin_amdgcn_exp2f(mx[ai][m] - M) / L;
                bf16_t* rowp = O + (size_t)(row0 + ai * HALF + m * 16) * ldc + col0;
#pragma unroll
                for (int bj = 0; bj < 2; ++bj) { const f32x4 v0 = acc[ai][bj][m][0] * f, v1 = acc[ai][bj][m][1] * f;
                    u32x4 w; w.x = cvt_pk_bf16(v0[0], v0[1]); w.y = cvt_pk_bf16(v0[2], v0[3]); w.z = cvt_pk_bf16(v1[0], v1[1]); w.w = cvt_pk_bf16(v1[2], v1[3]);
                    *(u32x4*)(rowp + bj * HALF) = w; }
                asm volatile("" ::: "memory"); __builtin_amdgcn_sched_barrier(0); }
        asm volatile("s_waitcnt lgkmcnt(0)" ::: "memory"); __builtin_amdgcn_s_barrier(); asm volatile("" ::: "memory");
    }
};

template <class Epi, class Sched, bool ALIGN_EPI = false, bool SP2 = false>
__device__ __forceinline__ void gemm_phase(PG8_LAS unsigned char* lds, const Gemm g, const Sched& S, const Epi& E) {
    int tid_ = threadIdx.x; asm volatile("" : "+v"(tid_));
    const int tid = tid_, wid = __builtin_amdgcn_readfirstlane(tid >> 6), lane = tid & 63, wr = wid >> 2, wc = wid & 3, fr = lane & 15, fq = lane >> 4;
    const int K = g.K, nt = K / BK;
    unsigned voffA[2], voffB[2];
#pragma unroll
    for (int i = 0; i < 2; ++i) { int R, C; stage_rc(tid * 16 + i * 8192, R, C); const int Rb = Epi::PERM ? ((R & ~31) + perm32(R & 31)) : R;
        voffA[i] = (unsigned)(R * g.lda + C) * 2u; voffB[i] = (unsigned)(Rb * g.ldb + C) * 2u; }
    const size_t kstep = (size_t)(BK * 2);
    const size_t hstepA = (size_t)HALF * g.lda * 2, hstepB = (size_t)HALF * g.ldb * 2;
    const unsigned ldsbase = (unsigned)(uintptr_t)lds;
    const unsigned ldsw = (unsigned)wid * 1024u;
    const int aoff = lds_byte(wr * 64 + fr, fq * 8), boff = lds_byte(wc * 32 + fr, fq * 8);
#define PG8_SA(b, h) (((b) * 2 + (h)) * HTB)
#define PG8_SB(b, h) ((4 + (b) * 2 + (h)) * HTB)
#define PG8_STAGE(bufoff, gbase, voff) do { _Pragma("unroll") for (int _i = 0; _i < 2; ++_i) \
        glds16s((const void*)(gbase), (voff)[_i], (unsigned)__builtin_amdgcn_readfirstlane((int)(ldsbase + (unsigned)(bufoff) + ldsw + (unsigned)(_i * 8192)))); } while (0)
#define PG8_LDA(dst, b, h) do { _Pragma("unroll") for (int m = 0; m < 4; ++m) _Pragma("unroll") for (int k = 0; k < 2; ++k) dst[m][k] = *(const PG8_LAS bf16x8*)(lds + PG8_SA(b, h) + aoff + m * 2048 + k * 1024); } while (0)
#define PG8_LDB(dst, b, h) do { _Pragma("unroll") for (int n = 0; n < 2; ++n) _Pragma("unroll") for (int k = 0; k < 2; ++k) dst[n][k] = *(const PG8_LAS bf16x8*)(lds + PG8_SB(b, h) + boff + n * 2048 + k * 1024); } while (0)
#define PG8_MMA(ai, bj, At, Bt) do { __builtin_amdgcn_s_setprio(1); _Pragma("unroll") for (int m = 0; m < 4; ++m) _Pragma("unroll") for (int n = 0; n < 2; ++n) _Pragma("unroll") for (int k = 0; k < 2; ++k) \
        acc[ai][bj][m][n] = __builtin_amdgcn_mfma_f32_16x16x32_bf16(Bt[n][k], At[m][k], acc[ai][bj][m][n], 0, 0, 0); __builtin_amdgcn_s_setprio(0); } while (0)
#define PG8_WAIT_V(n) asm volatile("s_waitcnt vmcnt(" #n ")" ::: "memory")
#define PG8_WAIT_L(n) asm volatile("s_waitcnt lgkmcnt(" #n ")" ::: "memory")
#define PG8_BAR __builtin_amdgcn_s_barrier()
#define PG8_SCHED __builtin_amdgcn_sched_barrier(0)
    Unit cur, nxt; int ui = 0;
    if (!S.next(0, cur)) return;
    f32x4 acc[2][2][4][2];
#pragma unroll
    for (int a = 0; a < 2; ++a)
#pragma unroll
        for (int b = 0; b < 2; ++b)
#pragma unroll
            for (int m = 0; m < 4; ++m)
#pragma unroll
                for (int n = 0; n < 2; ++n) acc[a][b][m][n] = (f32x4){0.f, 0.f, 0.f, 0.f};
    bf16x8 At[4][2], B0[2][2], B1[2][2];
    const char* cA = (const char*)g.A + cur.ao * 2; const char* cB = (const char*)g.Bt + cur.bo * 2;
    S.a_ready(cur);
    if constexpr (SP2) {
        PG8_STAGE(PG8_SB(0, 0), cB, voffB); PG8_STAGE(PG8_SB(0, 1), cB + hstepB, voffB); PG8_STAGE(PG8_SA(0, 0), cA, voffA); PG8_STAGE(PG8_SA(0, 1), cA + hstepA, voffA);
        if (wr == 1) PG8_BAR;
        PG8_WAIT_V(2); PG8_BAR;
        PG8_STAGE(PG8_SB(1, 0), cB + kstep, voffB); PG8_STAGE(PG8_SA(1, 0), cA + kstep, voffA); PG8_STAGE(PG8_SB(1, 1), cB + hstepB + kstep, voffB);
        PG8_WAIT_V(6); PG8_BAR;
    } else {
        PG8_STAGE(PG8_SB(0, 0), cB, voffB); PG8_STAGE(PG8_SA(0, 0), cA, voffA); PG8_STAGE(PG8_SB(0, 1), cB + hstepB, voffB); PG8_STAGE(PG8_SA(0, 1), cA + hstepA, voffA);
        if (wr == 1) PG8_BAR;
        PG8_WAIT_V(4); PG8_BAR;
        PG8_STAGE(PG8_SB(1, 0), cB + kstep, voffB); PG8_STAGE(PG8_SA(1, 0), cA + kstep, voffA); PG8_STAGE(PG8_SB(1, 1), cB + hstepB + kstep, voffB);
        PG8_WAIT_V(6); PG8_BAR;
    }
    for (;;) {
        const bool has_next = S.next(ui + 1, nxt);
        const char* nA = has_next ? (const char*)g.A + nxt.ao * 2 : cA; const char* nB = has_next ? (const char*)g.Bt + nxt.bo * 2 : cB;
        for (int t = 0; t < nt; t += 2) {
            if (E.stat != nullptr && t == (nt >> 1)) E.mid(acc, cur, wr);
            const bool last = (t == nt - 2);
            const char* a1 = cA + (size_t)(t + 1) * kstep;
            const char* a2 = last ? nA : cA + (size_t)(t + 2) * kstep; const char* b2 = last ? nB : cB + (size_t)(t + 2) * kstep;
            const char* a3 = a2 + kstep; const char* b3 = b2 + kstep;
            if (last && has_next) S.a_ready(nxt);
            if constexpr (SP2) {
            PG8_LDB(B0, 0, 0); PG8_LDB(B1, 0, 1); PG8_SCHED; PG8_LDA(At, 0, 0); PG8_STAGE(PG8_SA(1, 1), a1 + hstepA, voffA);
            PG8_WAIT_V(8); PG8_WAIT_L(0); PG8_BAR; PG8_MMA(0, 0, At, B0); PG8_MMA(0, 1, At, B1); PG8_BAR; PG8_SCHED;
            PG8_LDA(At, 0, 1); PG8_STAGE(PG8_SB(0, 0), b2, voffB); PG8_STAGE(PG8_SB(0, 1), b2 + hstepB, voffB); PG8_STAGE(PG8_SA(0, 0), a2, voffA);
            PG8_WAIT_V(8); PG8_WAIT_L(0); PG8_BAR; PG8_MMA(1, 0, At, B0); PG8_MMA(1, 1, At, B1); PG8_BAR; PG8_SCHED;
            PG8_LDB(B0, 1, 0); PG8_LDB(B1, 1, 1); PG8_SCHED; PG8_LDA(At, 1, 0); PG8_STAGE(PG8_SA(0, 1), a2 + hstepA, voffA);
            PG8_WAIT_V(8); PG8_WAIT_L(0); PG8_BAR; PG8_MMA(0, 0, At, B0); PG8_MMA(0, 1, At, B1); PG8_BAR; PG8_SCHED;
            PG8_LDA(At, 1, 1); PG8_STAGE(PG8_SB(1, 0), b3, voffB); PG8_STAGE(PG8_SB(1, 1), b3 + hstepB, voffB); PG8_STAGE(PG8_SA(1, 0), a3, voffA);
            PG8_WAIT_V(8); PG8_WAIT_L(0); PG8_BAR; PG8_MMA(1, 0, At, B0); PG8_MMA(1, 1, At, B1); PG8_BAR; PG8_SCHED;
            } else {
            PG8_LDB(B0, 0, 0); PG8_SCHED; PG8_LDA(At, 0, 0); PG8_STAGE(PG8_SA(1, 1), a1 + hstepA, voffA);
            PG8_WAIT_L(8); PG8_BAR; PG8_WAIT_L(0); PG8_MMA(0, 0, At, B0); PG8_BAR; PG8_SCHED;
            PG8_LDB(B1, 0, 1); PG8_STAGE(PG8_SB(0, 0), b2, voffB);
            PG8_BAR; PG8_WAIT_L(0); PG8_MMA(0, 1, At, B1); PG8_BAR;
            PG8_LDA(At, 0, 1); PG8_STAGE(PG8_SA(0, 0), a2, voffA);
            PG8_BAR; PG8_WAIT_L(0); PG8_MMA(1, 0, At, B0); PG8_BAR; PG8_SCHED;
            PG8_STAGE(PG8_SB(0, 1), b2 + hstepB, voffB);
            PG8_WAIT_V(6); PG8_BAR; PG8_MMA(1, 1, At, B1); PG8_BAR;
            PG8_LDB(B0, 1, 0); PG8_SCHED; PG8_LDA(At, 1, 0); PG8_STAGE(PG8_SA(0, 1), a2 + hstepA, voffA);
            PG8_WAIT_L(8); PG8_BAR; PG8_WAIT_L(0); PG8_MMA(0, 0, At, B0); PG8_BAR; PG8_SCHED;
            PG8_LDB(B1, 1, 1); PG8_STAGE(PG8_SB(1, 0), b3, voffB);
            PG8_BAR; PG8_WAIT_L(0); PG8_MMA(0, 1, At, B1); PG8_BAR;
            PG8_LDA(At, 1, 1); PG8_STAGE(PG8_SA(1, 0), a3, voffA);
            PG8_BAR; PG8_WAIT_L(0); PG8_MMA(1, 0, At, B0); PG8_BAR; PG8_SCHED;
            PG8_STAGE(PG8_SB(1, 1), b3 + hstepB, voffB);
            PG8_WAIT_V(6); PG8_BAR; PG8_MMA(1, 1, At, B1); PG8_BAR;
            }
        }
        if constexpr (ALIGN_EPI) { if (wr == 0) PG8_BAR; }
        if constexpr (!Epi::AFTER_DRAIN) { E(acc, cur, wr, wc, fr, fq); S.done(cur); }
        if (!has_next) break;
#pragma unroll
        for (int a = 0; a < 2; ++a)
#pragma unroll
            for (int b = 0; b < 2; ++b)
#pragma unroll
                for (int m = 0; m < 4; ++m)
#pragma unroll
                    for (int n = 0; n < 2; ++n) acc[a][b][m][n] = (f32x4){0.f, 0.f, 0.f, 0.f};
        cur = nxt; cA = nA; cB = nB; ++ui;
        if constexpr (ALIGN_EPI) { if (wr == 1) PG8_BAR; }
    }
    PG8_WAIT_V(0);
    if constexpr (!ALIGN_EPI) { if (wr == 0) PG8_BAR; }
    PG8_BAR;
    if constexpr (Epi::AFTER_DRAIN) { E.fused(acc, cur, wr, wc, fr, fq, lds, wid, lane); S.done(cur); }
#undef PG8_SA
#undef PG8_SB
#undef PG8_STAGE
#undef PG8_LDA
#undef PG8_LDB
#undef PG8_MMA
#undef PG8_WAIT_V
#undef PG8_WAIT_L
#undef PG8_BAR
#undef PG8_SCHED
}
}

#include <hip/hip_bf16.h>
#include <cmath>
namespace attn_body {
using bf16=__hip_bfloat16;
using bf16x8=__attribute__((ext_vector_type(8)))short;
using s16x4=__attribute__((ext_vector_type(4)))short;
using f32x16=__attribute__((ext_vector_type(16)))float;
using u32x4=__attribute__((ext_vector_type(4)))unsigned;
constexpr int SEQ=16384,D=64,PQ=3072,PO=1024;
constexpr int NW=8,QBLK=32,QB=QBLK*NW,KVBLK=64,NQB=SEQ/QB;
constexpr int ATTN_UNIT_ROWS=QB;
__device__ __forceinline__ int crow(int r,int hi){return (r&3)+8*(r>>2)+4*hi;}
#define SBAR() __builtin_amdgcn_sched_barrier(0)
__device__ __forceinline__ void cmask(f32x16&p0,f32x16&p1,int jb,int qrel,int hi){
  const float NEG=-INFINITY; int kb=64*jb+4*hi;
  #pragma unroll
  for(int r=0;r<16;++r){int kv=kb+(r&3)+8*(r>>2); if(kv>qrel)p0[r]=NEG; if(kv+32>qrel)p1[r]=NEG;}
}

__device__ __forceinline__ unsigned f2bf_rne(float f){unsigned u=__builtin_bit_cast(unsigned,f);return (u+0x7fffu+((u>>16)&1u))>>16;}
__device__ __forceinline__ unsigned pack_hilo(float v){const unsigned hb=f2bf_rne(v);const float hf=__builtin_bit_cast(float,hb<<16);const unsigned lb=f2bf_rne(v-hf);return hb|(lb<<16);}
typedef float f32x4v __attribute__((ext_vector_type(4)));
__device__ __forceinline__ void cbias(f32x16&p0,f32x16&p1,int dj,int qloc,int hi,const __attribute__((address_space(3))) float*E){
  const int j0=254-(qloc+64*dj+63-4*hi), a=j0&3;
  const __attribute__((address_space(3))) f32x4v* ep=(const __attribute__((address_space(3))) f32x4v*)(E+a*260+(j0&~3));
  #pragma unroll
  for(int g=0;g<4;++g){ const f32x4v v0=ep[2*g], v1=ep[2*g+8];
    p0[4*g]+=v0[0];p0[4*g+1]+=v0[1];p0[4*g+2]+=v0[2];p0[4*g+3]+=v0[3]; p1[4*g]+=v1[0];p1[4*g+1]+=v1[1];p1[4*g+2]+=v1[2];p1[4*g+3]+=v1[3]; }
}
constexpr int NSLOT=3, SLOTB=8192;
constexpr int LDS_K=0, LDS_V=NSLOT*SLOTB, LDS_WS=2*NSLOT*SLOTB, LDS_OST=LDS_WS+NW*64*4, LDS_CB=LDS_OST+NW*4096, LDS_BYTES=LDS_CB+65536;
constexpr float C2=0.125f*1.4426950408889634f;
__device__ __forceinline__ void glds16(const void*gsrc,unsigned lds_dst){unsigned keep;
  asm volatile("s_mov_b32 %0, m0\n\ts_mov_b32 m0, %2\n\ts_nop 0\n\tglobal_load_lds_dwordx4 %1, off\n\ts_mov_b32 m0, %0":"=&s"(keep):"v"(gsrc),"s"(lds_dst):"memory");}
__device__ __forceinline__ void glds16sa(const void*sbase,unsigned voff,unsigned lds_dst){unsigned keep;
  asm volatile("s_mov_b32 %0, m0\n\ts_mov_b32 m0, %3\n\ts_nop 0\n\tglobal_load_lds_dwordx4 %1, %2\n\ts_mov_b32 m0, %0":"=&s"(keep):"v"(voff),"s"(sbase),"s"(lds_dst):"memory");}
template<int MASK> __device__ __forceinline__ float swzx(float v){return __builtin_bit_cast(float,__builtin_amdgcn_ds_swizzle(__builtin_bit_cast(int,v),(MASK<<10)|0x1f));}
__device__ __forceinline__ float max3f(float a,float b,float c){float r;asm("v_max3_f32 %0, %1, %2, %3":"=v"(r):"v"(a),"v"(b),"v"(c));return r;}
__device__ __forceinline__ float max2f(float a,float b){float r;asm("v_max_f32_e32 %0, %1, %2":"=v"(r):"v"(a),"v"(b));return r;}
__device__ __forceinline__ float fadd_s(float a,float b){float r;asm("v_add_f32_e32 %0, %1, %2":"=v"(r):"v"(a),"v"(b));return r;}
__device__ __forceinline__ float fsub_s(float a,float b){float r;asm("v_sub_f32_e32 %0, %1, %2":"=v"(r):"v"(a),"v"(b));return r;}
typedef float f32x2_t __attribute__((ext_vector_type(2))); typedef __bf16 bf16x2_t __attribute__((ext_vector_type(2)));
__device__ __forceinline__ unsigned cvtpk_s(float lo,float hi){f32x2_t v={lo,hi};bf16x2_t b=__builtin_convertvector(v,bf16x2_t);return __builtin_bit_cast(unsigned,b);}
#define WAIT_BAR(N) asm volatile("s_waitcnt vmcnt(" #N ") lgkmcnt(0)\n\ts_barrier":::"memory")

__device__ __forceinline__ void qkt(f32x16&p0,f32x16&p1,const char*Kslot,const bf16x8*qr,const f32x16&c0i,const f32x16&c1i,int r32,int hi){
  const char*kb=Kslot+hi*1024+r32*16;
  #pragma unroll
  for(int d0=0;d0<4;++d0){
    const bf16x8 b0=*reinterpret_cast<const bf16x8*>(kb+d0*2048);
    const bf16x8 b1=*reinterpret_cast<const bf16x8*>(kb+d0*2048+512);
    if(d0==0){p0=__builtin_amdgcn_mfma_f32_32x32x16_bf16(b0,qr[0],c0i,0,0,0);p1=__builtin_amdgcn_mfma_f32_32x32x16_bf16(b1,qr[0],c1i,0,0,0);}
    else{p0=__builtin_amdgcn_mfma_f32_32x32x16_bf16(b0,qr[d0],p0,0,0,0);p1=__builtin_amdgcn_mfma_f32_32x32x16_bf16(b1,qr[d0],p1,0,0,0);}}
}
typedef __attribute__((address_space(3))) const char* lds_cptr;
typedef short v4i16_t __attribute__((ext_vector_type(4)));
__device__ __forceinline__ void kload8(bf16x8*kf,lds_cptr kp){
  kf[0]=*(const __attribute__((address_space(3))) bf16x8*)(kp);      kf[1]=*(const __attribute__((address_space(3))) bf16x8*)(kp+512);
  kf[2]=*(const __attribute__((address_space(3))) bf16x8*)(kp+2048); kf[3]=*(const __attribute__((address_space(3))) bf16x8*)(kp+2560);
  kf[4]=*(const __attribute__((address_space(3))) bf16x8*)(kp+4096); kf[5]=*(const __attribute__((address_space(3))) bf16x8*)(kp+4608);
  kf[6]=*(const __attribute__((address_space(3))) bf16x8*)(kp+6144); kf[7]=*(const __attribute__((address_space(3))) bf16x8*)(kp+6656);
}
__device__ __forceinline__ void kload2(bf16x8*kf,lds_cptr kp,int j){ kf[2*j]=*(const __attribute__((address_space(3))) bf16x8*)(kp+j*2048); kf[2*j+1]=*(const __attribute__((address_space(3))) bf16x8*)(kp+j*2048+512); }
__device__ __forceinline__ s16x4 vtr(lds_cptr p){ return __builtin_bit_cast(s16x4,__builtin_amdgcn_ds_read_tr16_b64_v4i16((__attribute__((address_space(3))) v4i16_t*)p)); }
__device__ __forceinline__ float rowmax(const f32x16&p0,const f32x16&p1){
  float a=max3f(p0[0],p0[1],p1[0]),b=max3f(p0[2],p0[3],p1[1]);a=max3f(a,p1[2],p1[3]);
  #pragma unroll
  for(int r=4;r<16;r+=4){a=max3f(a,p0[r],p0[r+1]);b=max3f(b,p0[r+2],p0[r+3]);a=max3f(a,p1[r],p1[r+1]);b=max3f(b,p1[r+2],p1[r+3]);}
  const float m=max2f(a,b);
  auto rr=__builtin_amdgcn_permlane32_swap(__float_as_uint(m),__float_as_uint(m),false,false);
  return max2f(__uint_as_float(rr[0]),__uint_as_float(rr[1]));
}
__device__ __forceinline__ void pv(f32x16*o,int vb,bf16x8 pa0,bf16x8 pa1,bf16x8 pa2,bf16x8 pa3){
  #pragma unroll
  for(int d0=0;d0<2;++d0){s16x4 lo[4],hi[4];
    #pragma unroll
    for(int ks=0;ks<4;++ks){
      asm volatile("ds_read_b64_tr_b16 %0,%1 offset:%c2":"=&v"(lo[ks]):"v"(vb),"i"(d0*4096+ks*1024):"memory");
      asm volatile("ds_read_b64_tr_b16 %0,%1 offset:%c2":"=&v"(hi[ks]):"v"(vb),"i"(d0*4096+ks*1024+512):"memory");}
    asm volatile("s_waitcnt lgkmcnt(0)":::"memory");SBAR();
    #define PK(k) (bf16x8){lo[k][0],lo[k][1],lo[k][2],lo[k][3],hi[k][0],hi[k][1],hi[k][2],hi[k][3]}
    o[d0]=__builtin_amdgcn_mfma_f32_32x32x16_bf16(pa0,PK(0),o[d0],0,0,0);
    o[d0]=__builtin_amdgcn_mfma_f32_32x32x16_bf16(pa1,PK(1),o[d0],0,0,0);
    o[d0]=__builtin_amdgcn_mfma_f32_32x32x16_bf16(pa2,PK(2),o[d0],0,0,0);
    o[d0]=__builtin_amdgcn_mfma_f32_32x32x16_bf16(pa3,PK(3),o[d0],0,0,0);
    #undef PK
  }
}

#ifndef ATTN_STORE16
#define ATTN_STORE16(p,v) (*(u32x4*)(p)=(v))
#endif
template<int MODE,int THRL> __device__ __forceinline__ void attn_unit(int b,int h,int qb,const bf16*Q,const bf16*__restrict__ K,const bf16*__restrict__ V,bf16*O,char*shm,const float*aux,float*stat){
  int tid_=threadIdx.x; asm volatile("":"+v"(tid_));
  const int tid=tid_,lane=tid&63,r32=lane&31,hi=lane>>5; const int wid=__builtin_amdgcn_readfirstlane(tid>>6);
  const long rowbase=(long)b*SEQ; const int q0=qb*QB;
  const int t0=(MODE==1)?((4*qb-8)>0?(4*qb-8):0):0;
  const bf16*Qw=Q+(rowbase+q0+wid*QBLK)*PQ+h*D;
  const bf16*Kh=K+(rowbase+(long)t0*KVBLK)*PQ+h*D,*Vh=V+(rowbase+(long)t0*KVBLK)*PQ+h*D;
  const unsigned lds0=(unsigned)(uintptr_t)shm;
  float*wsf=(float*)(shm+LDS_WS)+wid*64;
  const unsigned koff=(unsigned)((lane*PQ+wid*8)*2);
  const unsigned voff=(unsigned)(((16*(wid&3)+(lane>>2))*PQ+(wid>>2)*32+(lane&3)*8)*2);
  const unsigned kdst=lds0+LDS_K+wid*1024, vdst=lds0+LDS_V+wid*1024;
  #define DMA_K(t,slot) glds16sa(Kh+(long)(t)*KVBLK*PQ,koff,(unsigned)__builtin_amdgcn_readfirstlane(kdst+(slot)))
  #define DMA_V(t,slot) glds16sa(Vh+(long)(t)*KVBLK*PQ,voff,(unsigned)__builtin_amdgcn_readfirstlane(vdst+(slot)))
  const int vb0=(int)(lds0+LDS_V)+((lane>>4)&1)*32+(lane&3)*8+(4*hi+((lane&15)>>2))*64;
  const char*Kbase=shm+LDS_K; bf16x8 kf[8];
  const lds_cptr shm3=(lds_cptr)shm; const lds_cptr kp0=shm3+LDS_K+hi*1024+r32*16; const lds_cptr vp0=shm3+LDS_V+((lane>>4)&1)*32+(lane&3)*8+(4*hi+((lane&15)>>2))*64;
  const int NT=(q0+QB)/KVBLK-t0;
  __attribute__((address_space(3))) unsigned* CBt=(__attribute__((address_space(3))) unsigned*)(shm3+LDS_CB);
  __attribute__((address_space(3))) float* RBt=(__attribute__((address_space(3))) float*)(shm3+LDS_CB);
  const int cw=4*qb+(wid>>1), qloc=32*(wid&1)+r32; unsigned pkfar=0u;
  if constexpr(MODE==0){ const float cref=aux[q0];
    for(int s0_=0;s0_<q0+QB;s0_+=8*NW*64){ float cv_[8];
      _Pragma("unroll") for(int j_=0;j_<8;++j_){ const int s_=s0_+j_*NW*64+tid; cv_[j_]=(s_<q0+QB)?aux[s_]:0.f; }
      _Pragma("unroll") for(int j_=0;j_<8;++j_){ const int s_=s0_+j_*NW*64+tid; if(s_<q0+QB)CBt[s_]=pack_hilo((cref-cv_[j_])*1.4426950408889634f); } } }
  else { _Pragma("unroll") for(int k_=0;k_<3;++k_){ const int idx_=tid+NW*64*k_; if(idx_<1040){ const int a_=idx_/260, j_=idx_-260*a_, i_=254-(j_+a_); RBt[idx_]=(i_<0)?0.f:aux[i_>191?191:i_]*1.4426950408889634f; } }
    pkfar=pack_hilo(aux[191]*1.4426950408889634f); }
  u32x4 qfw={hi==0?0x3F803F80u:0u,0u,0u,0u};
  u32x4 kbw0={0u,0x3F803F80u,0x00003F80u,0u},kbw1={0u,0x3F803F80u,0x00003F80u,0u};
  #define QF __builtin_bit_cast(bf16x8,qfw)
  #define KBF(w) __builtin_bit_cast(bf16x8,w)
  #define wb0 kbw0
  #define wb1 kbw1
  #define SETQF() do{ const float nm_=-mhat; const unsigned h_=f2bf_rne(nm_); const float r1_=nm_-__builtin_bit_cast(float,h_<<16); const unsigned m_=f2bf_rne(r1_); \
      const float r2_=r1_-__builtin_bit_cast(float,m_<<16); const unsigned l_=f2bf_rne(r2_); qfw[1]=hi==0?(h_|(m_<<16)):0u; qfw[2]=hi==0?l_:0u; }while(0)
  #define LOADB(t) do{ if constexpr(MODE==0){ kbw0[0]=CBt[64*(t)+r32]; kbw1[0]=CBt[64*(t)+32+r32]; } else { const int dj_=cw-(t0+(t)); const unsigned w_=(dj_<0||dj_>8)?0xC4FAu:(dj_>=3?pkfar:0u); kbw0[0]=w_; kbw1[0]=w_; } }while(0)
  const f32x16 zero16=f32x16{};
  DMA_K(0,0);DMA_V(0,0);DMA_K(1,SLOTB);
  bf16x8 qr[4];
  #pragma unroll
  for(int d0=0;d0<4;++d0)qr[d0]=*reinterpret_cast<const bf16x8*>(&Qw[(long)r32*PQ+d0*16+hi*8]);
  float mhat=(MODE==0)?((aux[q0]-aux[q0+wid*QBLK+r32])*1.4426950408889634f+12.0f):8.0f,l_reg=0.f;f32x16 o[2];o[0]=f32x16{};o[1]=f32x16{};
  SETQF();
  const int qrel=wid*QBLK+r32;
  #define CMASK(P0,P1,t) do{ if constexpr(MODE==0){int jb_=(t)-(NT-4); if(jb_>=0)cmask(P0,P1,jb_,qrel,hi);} else {const int dq_=cw-(t0+(t)); if(dq_>=0&&dq_<=2)cbias(P0,P1,dq_,qloc,hi,RBt);} }while(0)
  bool resc=false;
  #define START(P0,P1) do{ const float rm=rowmax(P0,P1); resc=false; \
    { const float dl=__builtin_fmaxf(rm,0.f); mhat=fadd_s(mhat,dl); \
      _Pragma("unroll") for(int r=0;r<16;++r){P0[r]=fsub_s(P0[r],dl);P1[r]=fsub_s(P1[r],dl);} \
      SETQF(); } \
    _Pragma("unroll") for(int r=0;r<16;++r)P0[r]=__builtin_amdgcn_exp2f(P0[r]); }while(0)
  #define RESC() do{ if(resc){ asm volatile("s_waitcnt lgkmcnt(0)":::"memory"); \
      _Pragma("unroll") for(int d_=0;d_<2;++d_) _Pragma("unroll") for(int r=0;r<16;++r)o[d_][r]*=wsf[crow(r,hi)]; } }while(0)
  f32x16 pA0,pA1,pB0,pB1;
  int sl_prev=0,sl_cur=0,sl_next=SLOTB;
  #define ROT() do{sl_prev=sl_cur;sl_cur=sl_next;sl_next=(sl_next==(NSLOT-1)*SLOTB)?0:sl_next+SLOTB;}while(0)
  DMA_K(2,2*SLOTB);
  WAIT_BAR(3);
  LOADB(0);
  { const f32x16 cb0=__builtin_amdgcn_mfma_f32_32x32x16_bf16(KBF(wb0),QF,zero16,0,0,0), cb1=__builtin_amdgcn_mfma_f32_32x32x16_bf16(KBF(wb1),QF,zero16,0,0,0);
    qkt(pA0,pA1,Kbase,qr,cb0,cb1,r32,hi); }
  LOADB(1);
  asm volatile("s_nop 15\n\ts_nop 7":"+v"(pA0),"+v"(pA1));CMASK(pA0,pA1,0);
  START(pA0,pA1);
  _Pragma("unroll") for(int r=0;r<16;++r)pA1[r]=__builtin_amdgcn_exp2f(pA1[r]);
  WAIT_BAR(0);
  DMA_K(3,0);DMA_V(1,SLOTB);
  ROT();
  kload8(kf,kp0+sl_cur);
  WAIT_BAR(2);
  s16x4 vlo[8],vhi[8]; u32x4 pw0,pw1,pw2,pw3;
  #define PKW(P,B) cvtpk_s(P[B],P[B+1])
  #define PAF(k) __builtin_bit_cast(bf16x8,pw##k)
  #define VFR(i) (bf16x8){vlo[i][0],vlo[i][1],vlo[i][2],vlo[i][3],vhi[i][0],vhi[i][1],vhi[i][2],vhi[i][3]}
  #define PIN(x) asm volatile("":"+v"(x))
  #define MX3(a,b,c) __builtin_fmaxf(__builtin_fmaxf((a),(b)),(c))
  #define GAPA(MF,A0,A1,A2,A3,W0,W1,PW) do{ MF; sacc+=A0; sacc+=A1; sacc+=A2; sacc+=A3; PIN(sacc); W0; W1; PIN(PW); SBAR(); }while(0)
  #define EX(v) __builtin_amdgcn_exp2f(v)
  #define GAPB(MF,X,B) do{ MF; X[B]=EX(X[B]); X[B+1]=EX(X[B+1]); X[B+2]=EX(X[B+2]); X[B+3]=EX(X[B+3]); PIN(X); SBAR(); }while(0)
  #define VRD(i) do{ vlo[i]=vtr(vp_+(((i)>>2)*4096+((i)&3)*1024)); vhi[i]=vtr(vp_+(((i)>>2)*4096+((i)&3)*1024+512)); }while(0)
  #define KRD(G,j) do{ if(G){ kload2(kf,kp0+sl_next,j); SBAR(); } }while(0)
  #define STEP(C0,C1,P0,P1,t,GK,GV,GL) do{ SBAR(); \
    const lds_cptr vp_=vp0+sl_prev; \
    C0=__builtin_amdgcn_mfma_f32_32x32x16_bf16(KBF(wb0),QF,zero16,0,0,0); C1=__builtin_amdgcn_mfma_f32_32x32x16_bf16(KBF(wb1),QF,zero16,0,0,0); SBAR(); \
    VRD(0); SBAR(); float sacc=(P0[0]+P0[1]); \
    GAPA(C0=__builtin_amdgcn_mfma_f32_32x32x16_bf16(kf[0],qr[0],C0,0,0,0), P0[2],P0[3],P0[4],P0[5],     pw0[0]=PKW(P0,0), pw0[1]=PKW(P0,2), pw0); \
    VRD(4); SBAR(); GAPA(C1=__builtin_amdgcn_mfma_f32_32x32x16_bf16(kf[1],qr[0],C1,0,0,0), P0[6],P0[7],P0[8],P0[9],     pw0[2]=PKW(P0,4), pw0[3]=PKW(P0,6), pw0); \
    VRD(1); SBAR(); GAPA(C0=__builtin_amdgcn_mfma_f32_32x32x16_bf16(kf[2],qr[1],C0,0,0,0),   P0[10],P0[11],P0[12],P0[13], pw1[0]=PKW(P0,8), pw1[1]=PKW(P0,10), pw1); \
    VRD(5); SBAR(); GAPA(C1=__builtin_amdgcn_mfma_f32_32x32x16_bf16(kf[3],qr[1],C1,0,0,0),   P0[14],P0[15],P1[0],P1[1],   pw1[2]=PKW(P0,12),pw1[3]=PKW(P0,14), pw1); \
    VRD(2); SBAR(); GAPA(C0=__builtin_amdgcn_mfma_f32_32x32x16_bf16(kf[4],qr[2],C0,0,0,0),   P1[2],P1[3],P1[4],P1[5],     pw2[0]=PKW(P1,0), pw2[1]=PKW(P1,2), pw2); \
    VRD(6); SBAR(); GAPA(C1=__builtin_amdgcn_mfma_f32_32x32x16_bf16(kf[5],qr[2],C1,0,0,0),   P1[6],P1[7],P1[8],P1[9],     pw2[2]=PKW(P1,4), pw2[3]=PKW(P1,6), pw2); \
    VRD(3); SBAR(); GAPA(C0=__builtin_amdgcn_mfma_f32_32x32x16_bf16(kf[6],qr[3],C0,0,0,0),   P1[10],P1[11],P1[12],P1[13], pw3[0]=PKW(P1,8), pw3[1]=PKW(P1,10), pw3); \
    VRD(7); SBAR(); GAPA(C1=__builtin_amdgcn_mfma_f32_32x32x16_bf16(kf[7],qr[3],C1,0,0,0),   P1[14],P1[15],0.f,0.f,       pw3[2]=PKW(P1,12),pw3[3]=PKW(P1,14), pw3); \
    l_reg+=sacc; \
    if(GK){DMA_K((t)+3,sl_cur);} if(GV){DMA_V((t)+1,sl_next);} \
    CMASK(C0,C1,t); \
    { float a=MX3(C0[0],C0[1],C1[0]),b=MX3(C0[2],C0[3],C1[1]); a=MX3(a,C1[2],C1[3]); \
      _Pragma("unroll") for(int r=4;r<16;r+=4){a=MX3(a,C0[r],C0[r+1]);b=MX3(b,C0[r+2],C0[r+3]);a=MX3(a,C1[r],C1[r+1]);b=MX3(b,C1[r+2],C1[r+3]);} \
      float rm=__builtin_fmaxf(a,b); { auto rr=__builtin_amdgcn_permlane32_swap(__float_as_uint(rm),__float_as_uint(rm),false,false); rm=__builtin_fmaxf(__uint_as_float(rr[0]),__uint_as_float(rr[1])); } \
      resc=false; \
      if(__builtin_expect(__any(rm>(float)THRL),0)){ const float dl=__builtin_fmaxf(rm,0.f); mhat+=dl; \
        _Pragma("unroll") for(int r=0;r<16;++r){C0[r]-=dl;C1[r]-=dl;} \
        SETQF(); \
        const float f=__builtin_amdgcn_exp2f(-dl); l_reg*=f; if(hi==0)wsf[r32]=f; resc=true; } } \
    SBAR(); \
    GAPB(o[0]=__builtin_amdgcn_mfma_f32_32x32x16_bf16(PAF(0),VFR(0),o[0],0,0,0), C0,0); \
    GAPB(o[1]=__builtin_amdgcn_mfma_f32_32x32x16_bf16(PAF(0),VFR(4),o[1],0,0,0), C0,4); \
    KRD(GL,0); GAPB(o[0]=__builtin_amdgcn_mfma_f32_32x32x16_bf16(PAF(1),VFR(1),o[0],0,0,0), C0,8); \
    KRD(GL,1); GAPB(o[1]=__builtin_amdgcn_mfma_f32_32x32x16_bf16(PAF(1),VFR(5),o[1],0,0,0), C0,12); \
    KRD(GL,2); GAPB(o[0]=__builtin_amdgcn_mfma_f32_32x32x16_bf16(PAF(2),VFR(2),o[0],0,0,0), C1,0); \
    KRD(GL,3); GAPB(o[1]=__builtin_amdgcn_mfma_f32_32x32x16_bf16(PAF(2),VFR(6),o[1],0,0,0), C1,4); \
    GAPB(o[0]=__builtin_amdgcn_mfma_f32_32x32x16_bf16(PAF(3),VFR(3),o[0],0,0,0), C1,8); \
    GAPB(o[1]=__builtin_amdgcn_mfma_f32_32x32x16_bf16(PAF(3),VFR(7),o[1],0,0,0), C1,12); \
    if(GL){ LOADB((t)+1); } \
    }while(0)
  int t=1;
  #undef CMASK
  #define CMASK(P0,P1,t) do{ if constexpr(MODE==1){const int dq_=cw-(t0+(t)); if(dq_>=0&&dq_<=2)cbias(P0,P1,dq_,qloc,hi,RBt);} }while(0)
  for(;t+5<NT;t+=2){
    STEP(pB0,pB1,pA0,pA1,t,true,true,true);     WAIT_BAR(2); RESC(); ROT();
    STEP(pA0,pA1,pB0,pB1,t+1,true,true,true);   WAIT_BAR(2); RESC(); ROT();
  }
  #undef CMASK
  #define CMASK(P0,P1,t) do{ if constexpr(MODE==0){int jb_=(t)-(NT-4); if(jb_>=0)cmask(P0,P1,jb_,qrel,hi);} else {const int dq_=cw-(t0+(t)); if(dq_>=0&&dq_<=2)cbias(P0,P1,dq_,qloc,hi,RBt);} }while(0)
  #define ENDW(tt) do{ if((tt)+3<NT){WAIT_BAR(2);} else if((tt)+2<NT){WAIT_BAR(1);} else {WAIT_BAR(0);} }while(0)
  for(;t+1<NT;t+=2){
    STEP(pB0,pB1,pA0,pA1,t,(t+3<NT),(t+1<NT),(t+1<NT));       ENDW(t);   RESC(); ROT();
    STEP(pA0,pA1,pB0,pB1,t+1,(t+4<NT),(t+2<NT),(t+2<NT));     ENDW(t+1); RESC(); ROT();
  }
  STEP(pB0,pB1,pA0,pA1,NT-1,false,false,false); RESC();
  { float sacc=pB0[0]+pB0[1]; _Pragma("unroll") for(int r=2;r<16;++r)sacc+=pB0[r]; _Pragma("unroll") for(int r=0;r<16;++r)sacc+=pB1[r]; l_reg+=sacc;
    pw0=(u32x4){PKW(pB0,0),PKW(pB0,2),PKW(pB0,4),PKW(pB0,6)};pw1=(u32x4){PKW(pB0,8),PKW(pB0,10),PKW(pB0,12),PKW(pB0,14)};pw2=(u32x4){PKW(pB1,0),PKW(pB1,2),PKW(pB1,4),PKW(pB1,6)};pw3=(u32x4){PKW(pB1,8),PKW(pB1,10),PKW(pB1,12),PKW(pB1,14)};
    SBAR(); pv(o,vb0+sl_cur,PAF(0),PAF(1),PAF(2),PAF(3)); }
  #undef PKW
  #undef PAF
  #undef VFR
  #undef PIN
  #undef MX3
  #undef GAPA
  #undef GAPB
  #undef EX
  #undef VRD
  #undef KRD
  #undef STEP
  #undef ENDW
  { float la_=l_reg, lb_=l_reg; asm volatile("s_nop 1\n\tv_permlane32_swap_b32_e32 %0, %1\n\ts_nop 1":"+v"(la_),"+v"(lb_)); l_reg=la_+lb_; }
  if(hi==0)wsf[32+r32]=l_reg;asm volatile("s_waitcnt lgkmcnt(0)":::"memory");
  float rli[16];
  #pragma unroll
  for(int r=0;r<16;++r)rli[r]=__builtin_amdgcn_rcpf(__builtin_fmaxf(wsf[32+crow(r,hi)],1.0e-37f));
  bf16*Ow=O+(rowbase+q0+wid*QBLK)*PO+h*D;
  { bf16*stg=(bf16*)(shm+LDS_OST)+wid*2048;
    #pragma unroll
    for(int r=0;r<16;++r){const int orow=crow(r,hi);
      #pragma unroll
      for(int d0=0;d0<2;++d0)stg[orow*64+d0*32+r32]=__float2bfloat16(o[d0][r]*rli[r]);}
    asm volatile("s_waitcnt lgkmcnt(0)":::"memory");
    #pragma unroll
    for(int i=0;i<4;++i){const int row=i*8+(lane>>3),ch=lane&7; const u32x4 v=*(const u32x4*)(stg+row*64+ch*8); ATTN_STORE16(Ow+(long)row*PO+ch*8,v);
      float q_=0.f;
      #pragma unroll
      for(int e_=0;e_<4;++e_){const float lo_=__builtin_bit_cast(float,v[e_]<<16),hi_=__builtin_bit_cast(float,v[e_]&0xffff0000u); q_+=lo_*lo_+hi_*hi_;}
      q_+=swzx<1>(q_); q_+=swzx<2>(q_); q_+=swzx<4>(q_);
      if(ch==0)__hip_atomic_fetch_add(stat+((rowbase+q0+wid*QBLK+row)*2+MODE),q_,__ATOMIC_RELAXED,__HIP_MEMORY_SCOPE_AGENT);} }
  asm volatile("s_waitcnt lgkmcnt(0)\n\ts_barrier":::"memory");
  #undef DMA_K
  #undef KBF
  #undef wb0
  #undef wb1
  #undef QF
  #undef SETQF
  #undef LOADB
  #undef DMA_V
  #undef CMASK
  #undef START
  #undef RESC
  #undef ROT
}
constexpr int ATTN_LDS_BYTES=LDS_BYTES;
#undef SBAR
#undef WAIT_BAR
}

#define LAS __attribute__((address_space(3)))
#ifndef DBG_OFF
#define DBG_OFF 0
#endif
#ifndef PROBE_X2
#define PROBE_X2 0
#endif
typedef unsigned short u16;
typedef float f32x4 __attribute__((ext_vector_type(4)));
typedef unsigned v4u __attribute__((ext_vector_type(4)));
typedef unsigned v2u __attribute__((ext_vector_type(2)));

constexpr int T = 32768, DMODEL = 1024, SEQ = 16384, NLAYER = 2, DFF = 2816, INC = 3080, NMEM = 256;
constexpr float EPS = 1e-6f, LOG2E = 1.4426950408889634f;
constexpr float C2 = 0.125f * LOG2E;
constexpr float CM = 0.0625f * LOG2E;
constexpr size_t MiB = 1u << 20;
constexpr size_t WT_LAYER = 33 * MiB, W_QKV = 0, W_OUT = 6 * MiB, W_MQ = 8 * MiB, W_MKV = 10 * MiB, W_MO = 14 * MiB, W_GU = 16 * MiB, W_D = 27 * MiB;
constexpr size_t OFF_WT = 0, OFF_XB = 66 * MiB, OFF_OB = 130 * MiB, OFF_Y = 194 * MiB, OFF_QKV = 258 * MiB, OFF_QM = OFF_QKV, OFF_PM = OFF_QKV + 64 * MiB, OFF_HF = OFF_QKV;
constexpr size_t OFF_LF = 450 * MiB, OFF_CS = 451 * MiB, OFF_MN = 452 * MiB, OFF_KM = 453 * MiB, OFF_VM = 455 * MiB, OFF_CTL = 457 * MiB, OFF_STAT = OFF_CTL + 65536, CTL_BYTES = 65536 + 2 * 32768 * 2 * 4  , OFF_WQK = 458 * MiB, OFF_VWO = 466 * MiB, WS_END = 474 * MiB;
constexpr int LDS_BYTES = 155648;
constexpr int LDS_X_OFF = 131072;
constexpr int LDS_MISC_OFF = 149504;
static_assert(attn_body::ATTN_LDS_BYTES <= LDS_MISC_OFF && LDS_MISC_OFF + 16 <= LDS_BYTES && LDS_X_OFF + 8192 <= LDS_BYTES && pg8::STAGE_BYTES <= LDS_X_OFF, "LDS map");

__device__ __forceinline__ float wave_sum(float v) {
    v += pg8::swz_xor<1>(v); v += pg8::swz_xor<2>(v); v += pg8::swz_xor<4>(v); v += pg8::swz_xor<8>(v); v += pg8::swz_xor<16>(v);
    return pg8::half_sum(v);
}
__device__ __forceinline__ float log1p_exp_neg(float a) {
    const float t = __builtin_amdgcn_exp2f(-a * 1.4426950408889634f);
    const float ser = t * (1.0f + t * (-0.5f + t * (0.33333334f + t * (-0.25f + t * (0.2f + t * -0.16666667f)))));
    return t < 0.125f ? ser : __builtin_amdgcn_logf(1.0f + t) * 0.69314718056f;
}
__device__ __forceinline__ unsigned f2bf(float f) { unsigned u = __builtin_bit_cast(unsigned, f); return (u + 0x7fffu + ((u >> 16) & 1u)) >> 16; }
__device__ __forceinline__ unsigned pk2(float lo, float hi) { return f2bf(lo) | (f2bf(hi) << 16); }
__device__ __forceinline__ float bflo(unsigned w) { return __builtin_bit_cast(float, w << 16); }
__device__ __forceinline__ float bfhi(unsigned w) { return __builtin_bit_cast(float, w & 0xffff0000u); }

__device__ __forceinline__ void wt_item(const float* W, int K, int Nsrc, u16* WT, int drow, int scol, int k0, const float* gain, const float* gain2, float scale, LAS float* scr, int lane) {
    f32x4 v[8];
#pragma unroll
    for (int i = 0; i < 8; ++i) { const int kk = 8 * i + (lane >> 3); v[i] = *(const f32x4*)(W + (size_t)(k0 + kk) * Nsrc + scol + 4 * (lane & 7)); }
#pragma unroll
    for (int i = 0; i < 8; ++i) { const int kk = 8 * i + (lane >> 3), k = k0 + kk; float gsc = scale;
        if (gain) gsc *= (gain2 && k >= 512) ? gain2[k - 512] : gain[k];
        LAS float* d = scr + kk * 33 + 4 * (lane & 7); d[0] = v[i][0] * gsc; d[1] = v[i][1] * gsc; d[2] = v[i][2] * gsc; d[3] = v[i][3] * gsc; }
    asm volatile("s_waitcnt lgkmcnt(0)" ::: "memory");
    const int c = lane & 7;
#pragma unroll
    for (int j = 0; j < 4; ++j) { const int n = (lane >> 3) + 8 * j; const LAS float* s = scr + (8 * c) * 33 + n;
        v4u o; o.x = pk2(s[0 * 33], s[1 * 33]); o.y = pk2(s[2 * 33], s[3 * 33]); o.z = pk2(s[4 * 33], s[5 * 33]); o.w = pk2(s[6 * 33], s[7 * 33]);
        *(v4u*)(WT + (size_t)(drow + n) * K + k0 + 8 * c) = o; }
    asm volatile("s_waitcnt lgkmcnt(0)" ::: "memory");
}

template <bool HAS_Y>
__device__ __forceinline__ void rownorm_phase(const float* xin, const u16* Y, const float* gpost, float* xout, u16* XBo, bool write_xb, bool gates,
                                              const float* wsrc, const float* gpre, const float* bfg, float* LF, LAS float* WG, int gw, int NGW, int tid_, int lane_) {
    asm volatile("" : "+v"(tid_)); const int tid = tid_, lane = tid_ & 63; (void)lane_;
    if (gates) {
        float gq[16], wq[16];
#pragma unroll
        for (int i = 0; i < 16; ++i) { const int e = tid + 512 * i, c = e >> 3, h = e & 7; gq[i] = gpre[c]; wq[i] = wsrc[(size_t)c * INC + 1536 + h]; }
#pragma unroll
        for (int i = 0; i < 16; ++i) { const int e = tid + 512 * i, c = e >> 3, h = e & 7;
            WG[(((c >> 8) * 4 + (c & 3)) * 2 + (h >> 2)) * 256 + ((c & 255) >> 2) * 4 + (h & 3)] = gq[i] * wq[i]; }
        __syncthreads();
    }
    f32x4 gv[4];
#pragma unroll
    for (int j = 0; j < 4; ++j) gv[j] = HAS_Y ? *(const f32x4*)(gpost + 256 * j + 4 * lane) : (f32x4){0.f, 0.f, 0.f, 0.f};
    for (int m0 = gw; m0 < T; m0 += 2 * NGW) {
        f32x4 xv[2][4], yf[2][4]; float ry[2], r[2];
#pragma unroll
        for (int u = 0; u < 2; ++u) { const int m = m0 + u * NGW;
#pragma unroll
            for (int j = 0; j < 4; ++j) xv[u][j] = *(const f32x4*)(xin + (size_t)m * DMODEL + 256 * j + 4 * lane);
            if (HAS_Y) {
#pragma unroll
                for (int j = 0; j < 4; ++j) { const v2u w = *(const v2u*)(Y + (size_t)m * DMODEL + 256 * j + 4 * lane); yf[u][j] = (f32x4){bflo(w.x), bfhi(w.x), bflo(w.y), bfhi(w.y)}; }
            }
        }
#pragma unroll
        for (int u = 0; u < 2; ++u) { const int m = m0 + u * NGW;
            if (HAS_Y) {
                float sy = 0.f;
#pragma unroll
                for (int j = 0; j < 4; ++j) sy += (yf[u][j][0] * yf[u][j][0] + yf[u][j][1] * yf[u][j][1]) + (yf[u][j][2] * yf[u][j][2] + yf[u][j][3] * yf[u][j][3]);
                sy = wave_sum(sy); ry[u] = 1.0f / sqrtf(sy * (1.0f / DMODEL) + EPS);
#pragma unroll
                for (int j = 0; j < 4; ++j) { xv[u][j] = xv[u][j] + yf[u][j] * ry[u] * gv[j]; *(f32x4*)(xout + (size_t)m * DMODEL + 256 * j + 4 * lane) = xv[u][j]; }
            }
            float sx = 0.f;
#pragma unroll
            for (int j = 0; j < 4; ++j) sx += (xv[u][j][0] * xv[u][j][0] + xv[u][j][1] * xv[u][j][1]) + (xv[u][j][2] * xv[u][j][2] + xv[u][j][3] * xv[u][j][3]);
            sx = wave_sum(sx); r[u] = 1.0f / sqrtf(sx * (1.0f / DMODEL) + EPS);
            if (write_xb) {
#pragma unroll
                for (int j = 0; j < 4; ++j) { v2u o; o.x = pk2(xv[u][j][0] * r[u], xv[u][j][1] * r[u]); o.y = pk2(xv[u][j][2] * r[u], xv[u][j][3] * r[u]); *(v2u*)(XBo + (size_t)m * DMODEL + 256 * j + 4 * lane) = o; }
            }
            if (gates) {
                float a0 = 0.f, a1 = 0.f, a2 = 0.f, a3 = 0.f, a4 = 0.f, a5 = 0.f, a6 = 0.f, a7 = 0.f;
#pragma unroll
                for (int j = 0; j < 4; ++j)
#pragma unroll
                    for (int i = 0; i < 4; ++i) { const float xn = xv[u][j][i] * r[u];
                        const f32x4 w0 = *(const LAS f32x4*)(WG + ((j * 4 + i) * 2 + 0) * 256 + lane * 4), w1 = *(const LAS f32x4*)(WG + ((j * 4 + i) * 2 + 1) * 256 + lane * 4);
                        a0 += xn * w0[0]; a1 += xn * w0[1]; a2 += xn * w0[2]; a3 += xn * w0[3]; a4 += xn * w1[0]; a5 += xn * w1[1]; a6 += xn * w1[2]; a7 += xn * w1[3]; }
                a0 = wave_sum(a0); a1 = wave_sum(a1); a2 = wave_sum(a2); a3 = wave_sum(a3); a4 = wave_sum(a4); a5 = wave_sum(a5); a6 = wave_sum(a6); a7 = wave_sum(a7);
                float z = a0; z = lane == 1 ? a1 : z; z = lane == 2 ? a2 : z; z = lane == 3 ? a3 : z; z = lane == 4 ? a4 : z; z = lane == 5 ? a5 : z; z = lane == 6 ? a6 : z; z = lane == 7 ? a7 : z;
                if (lane < 8) { z += bfg[lane]; LF[((size_t)(m / SEQ) * 8 + lane) * SEQ + (m % SEQ)] = fminf(z, 0.f) - log1p_exp_neg(fabsf(z)); }
            }
        }
    }
    __syncthreads();
}

#define XB_TMO      128
#define XB_XCNT(j)  (256  + 64 * (j))
#define XB_XSUB(j)  (1280 + 64 * (j))
#define XB_XGEN(j)  (2304 + 64 * (j))
#define XB_TOP      3328
#define XB_TOPGEN   3392
#define XCD_BAR_WORDS 3456
#define XB_SPIN_CAP (1u << 18)

__device__ __forceinline__ unsigned xb_ld(unsigned* p)              { return __hip_atomic_load(p, __ATOMIC_RELAXED, __HIP_MEMORY_SCOPE_AGENT); }
__device__ __forceinline__ unsigned xb_add(unsigned* p, unsigned v) { return __hip_atomic_fetch_add(p, v, __ATOMIC_RELAXED, __HIP_MEMORY_SCOPE_AGENT); }
__device__ __forceinline__ unsigned xb_xcc_id() { return (unsigned)__builtin_amdgcn_s_getreg((3 << 11) | 20) & 0xFu; }
#define XB_SPIN(cond, bar) do { unsigned _sp = 0; while (cond) { __builtin_amdgcn_s_sleep(1); \
    if ((++_sp & 255u) == 0u) { if (xb_ld(&(bar)[XB_TMO])) break; if (_sp > XB_SPIN_CAP) { atomicAdd(&(bar)[XB_TMO], 1u); break; } } } } while (0)

struct XcdBarrier {
    unsigned* bar; unsigned x;
    volatile LAS unsigned* st;
};

__device__ __forceinline__ XcdBarrier xcd_barrier_post(unsigned* bar, volatile LAS unsigned* st) {
    XcdBarrier b; b.bar = bar; b.x = xb_xcc_id(); b.st = st;
    if (threadIdx.x == 0) (void)xb_add(&bar[XB_XCNT(b.x)], 1u);
    return b;
}
__device__ __forceinline__ void xcd_barrier_complete(unsigned* bar, unsigned x, unsigned& nloc, unsigned& nx) {
    const unsigned G = gridDim.x * gridDim.y * gridDim.z;
    unsigned sum, cnt, mine, sp = 0u;
    for (;;) {
        sum = 0u; cnt = 0u; mine = 0u;
#pragma unroll
        for (unsigned j = 0; j < 16; ++j) { const unsigned c = xb_ld(&bar[XB_XCNT(j)]); sum += c; cnt += (c > 0u) ? 1u : 0u; mine = (j == x) ? c : mine; }
        if (sum == G) break;
        __builtin_amdgcn_s_sleep(1);
        if ((++sp & 255u) == 0u) { if (xb_ld(&bar[XB_TMO])) break; if (sp > XB_SPIN_CAP) { atomicAdd(&bar[XB_TMO], 1u); break; } }
    }
    nloc = mine > 0u ? mine : 1u; nx = cnt > 0u ? cnt : 1u;
}

__device__ __forceinline__ void xcd_barrier(const XcdBarrier& b) {
    asm volatile("s_waitcnt vmcnt(0)" ::: "memory");
    __syncthreads();
    if (threadIdx.x == 0) {
        unsigned* bar = b.bar;
        __builtin_amdgcn_s_waitcnt(0);
        unsigned nloc = b.st[0], nx = b.st[1];
        if (nloc == 0u) { xcd_barrier_complete(bar, b.x, nloc, nx); b.st[0] = nloc; b.st[1] = nx; }
        const unsigned old = xb_add(&bar[XB_XSUB(b.x)], 1u);
        const unsigned gen = old / nloc;
        if (old + 1u == (gen + 1u) * nloc) {
            __builtin_amdgcn_fence(__ATOMIC_RELEASE, "agent");
            asm volatile("s_waitcnt vmcnt(0)" ::: "memory");
            const unsigned og = xb_add(&bar[XB_TOP], 1u);
            const unsigned tg = og / nx;
            if (og + 1u == (tg + 1u) * nx) xb_add(&bar[XB_TOPGEN], 1u);
            else XB_SPIN(xb_ld(&bar[XB_TOPGEN]) == tg, bar);
            __builtin_amdgcn_fence(__ATOMIC_ACQUIRE, "agent");
            xb_add(&bar[XB_XGEN(b.x)], 1u);
            asm volatile("s_waitcnt vmcnt(0)" ::: "memory");
        } else {
            XB_SPIN(xb_ld(&bar[XB_XGEN(b.x)]) == gen, bar);
            __builtin_amdgcn_fence(__ATOMIC_ACQUIRE, "agent");
            asm volatile("s_waitcnt vmcnt(0)" ::: "memory");
        }
    }
    __syncthreads();
}

struct Params { const float* in[20]; float* out; unsigned char* ws; };

__global__ void __launch_bounds__(512, 2) fwd_kernel(Params p) {
    extern __shared__ __attribute__((aligned(16))) unsigned char lds[];
    cg::grid_group grid = cg::this_grid();
    LAS unsigned char* ldsL = (LAS unsigned char*)lds;
#define PHASE_IDS int tid_ = threadIdx.x; asm volatile("" : "+v"(tid_)); const int tid = tid_, lane = tid_ & 63, wave = __builtin_amdgcn_readfirstlane(tid_ >> 6), gw = vcu * 8 + wave; (void)tid; (void)lane; (void)gw;
    const int G = gridDim.x, bx = blockIdx.x;
    const int vcu = (G % 8 == 0) ? (bx % 8) * (G / 8) + bx / 8 : bx;
    const int NGW = G * 8;
    unsigned char* ws = p.ws;
    volatile LAS unsigned* MISC = (volatile LAS unsigned*)(ldsL + LDS_MISC_OFF);
    if (threadIdx.x < 4) MISC[threadIdx.x] = 0u;
    __syncthreads();
    XcdBarrier bar = xcd_barrier_post((unsigned*)(ws + OFF_CTL), MISC);
    const float* x_in = p.in[0]; const float* mem = p.in[1]; const float* g_mix_pre = p.in[2]; const float* w_in = p.in[3]; const float* b_fgate = p.in[4];
    const float* rel_bias = p.in[5]; const float* g_fox_out = p.in[6]; const float* g_chunk_out = p.in[7]; const float* w_out = p.in[8]; const float* g_mix_post = p.in[9];
    const float* g_mem_pre = p.in[10]; const float* g_mem_kv = p.in[11]; const float* w_mem_q = p.in[12]; const float* w_mem_kv = p.in[13]; const float* w_mem_o = p.in[14];
    const float* g_mem_post = p.in[15]; const float* g_ffn_pre = p.in[16]; const float* w_gate_up = p.in[17]; const float* w_down = p.in[18]; const float* g_ffn_post = p.in[19];
    u16* XB = (u16*)(ws + OFF_XB); u16* OB = (u16*)(ws + OFF_OB); u16* Yb = (u16*)(ws + OFF_Y); u16* QKV = (u16*)(ws + OFF_QKV);
    u16* PM = (u16*)(ws + OFF_PM); u16* HF = (u16*)(ws + OFF_HF); float* LF = (float*)(ws + OFF_LF); float* CS = (float*)(ws + OFF_CS); u16* MN = (u16*)(ws + OFF_MN);

    for (int rp_ = 0; rp_ < ((PROBE_X2 & 64) ? 2 : 1); ++rp_)
    if (!(DBG_OFF & 32)) {
        PHASE_IDS
        LAS float* scr = (LAS float*)(ldsL + wave * 16384);
        constexpr int I_QKV = 16 * 96, I_OUT = 16 * 32, I_MQ = 16 * 32, I_MKV = 16 * 64, I_MO = 16 * 32, I_GU = 16 * 176, I_D = 44 * 32, I_LAYER = I_QKV + I_OUT + I_MQ + I_MKV + I_MO + I_GU + I_D;
        for (int it = gw; it < NLAYER * I_LAYER; it += NGW) {
            const int l = it / I_LAYER; int r = it % I_LAYER; unsigned char* wl = ws + OFF_WT + (size_t)l * WT_LAYER;
            if (r < I_QKV) { const int kb = r / 96, n = 32 * (r % 96); const float sc = (n < 512 || (n >= 1536 && n < 2048)) ? C2 : 1.0f;
                wt_item(w_in + (size_t)l * DMODEL * INC, DMODEL, INC, (u16*)(wl + W_QKV), n, n < 1536 ? n : n + 8, 64 * kb, g_mix_pre + l * DMODEL, nullptr, sc, scr, lane); continue; } r -= I_QKV;
            if (r < I_OUT) { const int kb = r / 32, n = 32 * (r % 32);
                wt_item(w_out + (size_t)l * DMODEL * DMODEL, DMODEL, DMODEL, (u16*)(wl + W_OUT), n, n, 64 * kb, g_fox_out + l * 512, g_chunk_out + l * 512, 1.0f, scr, lane); continue; } r -= I_OUT;
            if (r < I_MQ) {
#pragma unroll
                for (int rr = 0; rr < 2; ++rr) { const int k = 2 * r + rr; const float gsc = g_mem_pre[l * DMODEL + k] * CM; const float* src = w_mem_q + ((size_t)l * DMODEL + k) * DMODEL; u16* dst = (u16*)(wl + W_MQ) + (size_t)k * DMODEL;
#pragma unroll
                    for (int j = 0; j < 4; ++j) { const f32x4 v = *(const f32x4*)(src + 256 * j + 4 * lane); v2u o; o.x = pk2(v[0] * gsc, v[1] * gsc); o.y = pk2(v[2] * gsc, v[3] * gsc); *(v2u*)(dst + 256 * j + 4 * lane) = o; } }
                continue; } r -= I_MQ;
            if (r < I_MKV) { const int kb = r / 64, n = 32 * (r % 64);
                wt_item(w_mem_kv + (size_t)l * DMODEL * 2 * DMODEL, DMODEL, 2 * DMODEL, (u16*)(wl + W_MKV), n, n, 64 * kb, g_mem_kv + l * DMODEL, nullptr, 1.0f, scr, lane); continue; } r -= I_MKV;
            if (r < I_MO) { const int kb = r / 32, n = 32 * (r % 32);
                wt_item(w_mem_o + (size_t)l * DMODEL * DMODEL, DMODEL, DMODEL, (u16*)(wl + W_MO), n, n, 64 * kb, nullptr, nullptr, 1.0f, scr, lane); continue; } r -= I_MO;
            if (r < I_GU) { const int kb = r / 176, n = 32 * (r % 176); const int scol = ((n >> 7) & 1) * DFF + 128 * (n >> 8) + (n & 127);
                wt_item(w_gate_up + (size_t)l * DMODEL * 2 * DFF, DMODEL, 2 * DFF, (u16*)(wl + W_GU), n, scol, 64 * kb, g_ffn_pre + l * DMODEL, nullptr, 1.0f, scr, lane); continue; } r -= I_GU;
            { const int kb = r / 32, n = 32 * (r % 32);
                wt_item(w_down + (size_t)l * DFF * DMODEL, DFF, DMODEL, (u16*)(wl + W_D), n, n, 64 * kb, nullptr, nullptr, 1.0f, scr, lane); }
        }
        for (int m = gw; m < 2 * NMEM; m += NGW) {
            f32x4 v[4]; float s = 0.f;
#pragma unroll
            for (int j = 0; j < 4; ++j) { v[j] = *(const f32x4*)(mem + (size_t)m * DMODEL + 256 * j + 4 * lane); s += (v[j][0] * v[j][0] + v[j][1] * v[j][1]) + (v[j][2] * v[j][2] + v[j][3] * v[j][3]); }
            s = wave_sum(s); const float r = 1.0f / sqrtf(s * (1.0f / DMODEL) + EPS);
#pragma unroll
            for (int j = 0; j < 4; ++j) { v2u o; o.x = pk2(v[j][0] * r, v[j][1] * r); o.y = pk2(v[j][2] * r, v[j][3] * r); *(v2u*)(MN + (size_t)m * DMODEL + 256 * j + 4 * lane) = o; }
        }
        __syncthreads();
        rownorm_phase<false>(x_in, nullptr, nullptr, nullptr, XB, true, true, w_in, g_mix_pre, b_fgate, LF, (LAS float*)ldsL, gw, NGW, tid, lane);
    }
    xcd_barrier(bar);
    if (ws == nullptr) grid.sync();

    for (int step = 0; step < 22; ++step) {
        const int l = step / 11, st = step % 11;
        if (st == 2) continue;
        float* STAT = (float*)(ws + OFF_STAT) + (size_t)l * T * 2;
        unsigned char* wl = ws + OFF_WT + (size_t)l * WT_LAYER;
        if (st == 1) {
            const attn_body::bf16* Qb = (const attn_body::bf16*)QKV; attn_body::bf16* Ob = (attn_body::bf16*)OB;
            for (int rp_ = 0; rp_ < ((PROBE_X2 & 1) ? 2 : 1); ++rp_)
            for (int w = vcu; w < 1024; w += G) { const int i = w >> 8, vv = w & 255, bh = vv >> 4, s = vv & 15; const int qb = (i == 0) ? s : (i == 1) ? 31 - s : (i == 2) ? 32 + s : 63 - s;
                if (!(DBG_OFF & 1)) attn_body::attn_unit<0, 64>(bh >> 3, bh & 7, qb, Qb, Qb + 512, Qb + 1024, Ob, (char*)lds, CS + (size_t)bh * SEQ, STAT); }
            for (int rp_ = 0; rp_ < ((PROBE_X2 & 2) ? 2 : 1); ++rp_)
            for (int w = vcu; w < 1024; w += G) { const int i = w >> 8, vv = w & 255, bh = vv >> 4, s = vv & 15; const int qb = 16 * i + s;
                if (!(DBG_OFF & 2)) attn_body::attn_unit<1, 64>(bh >> 3, bh & 7, qb, Qb + 1536, Qb + 2048, Qb + 2560, Ob + 512, (char*)lds, rel_bias + (size_t)(l * 8 + (bh & 7)) * 192, STAT); }
        } else if (st == 2) {
            PHASE_IDS
            if (!(DBG_OFF & 128)) for (int m = gw; m < T; m += NGW) {
                v2u w[4]; float sf = 0.f, sc = 0.f; f32x4 v[4];
#pragma unroll
                for (int j = 0; j < 4; ++j) { w[j] = *(const v2u*)(OB + (size_t)m * DMODEL + 256 * j + 4 * lane); v[j] = (f32x4){bflo(w[j].x), bfhi(w[j].x), bflo(w[j].y), bfhi(w[j].y)};
                    const float q = (v[j][0] * v[j][0] + v[j][1] * v[j][1]) + (v[j][2] * v[j][2] + v[j][3] * v[j][3]); if (j < 2) sf += q; else sc += q; }
                sf = wave_sum(sf); sc = wave_sum(sc);
                const float rf = 1.0f / sqrtf(sf * (1.0f / 512.0f) + EPS), rc = 1.0f / sqrtf(sc * (1.0f / 512.0f) + EPS);
#pragma unroll
                for (int j = 0; j < 4; ++j) { const float r = j < 2 ? rf : rc; v2u o; o.x = pk2(v[j][0] * r, v[j][1] * r); o.y = pk2(v[j][2] * r, v[j][3] * r); *(v2u*)(OB + (size_t)m * DMODEL + 256 * j + 4 * lane) = o; }
            }
        } else if (st == 4 || st == 7 || st == 10) {
            const float* gp = (st == 4 ? g_mix_post : st == 7 ? g_mem_post : g_ffn_post) + l * DMODEL;
            const float* xi = (l == 0 && st == 4) ? x_in : p.out;
            const bool gates = (st == 10 && l == 0), wxb = !(st == 10 && l == 1);
            PHASE_IDS
            if (PROBE_X2 & 32) rownorm_phase<true>(xi, Yb, gp, (float*)(ws + OFF_QKV), (u16*)(ws + OFF_QKV + 128 * MiB), true, false, w_in + (size_t)DMODEL * INC, g_mix_pre + DMODEL, b_fgate + 8, LF, (LAS float*)ldsL, gw, NGW, tid, lane);
            if (!(DBG_OFF & 64)) rownorm_phase<true>(xi, Yb, gp, p.out, XB, wxb, gates, w_in + (size_t)DMODEL * INC, g_mix_pre + DMODEL, b_fgate + 8, LF, (LAS float*)ldsL, gw, NGW, tid, lane);
        } else if (st == 5) {
            pg8::Gemm g{XB, (const u16*)(ws + OFF_WQK + (size_t)l * 4 * MiB), DMODEL, DMODEL, DMODEL}; pg8::Order S; S.init(T / 256, 4, G, bx, (size_t)256 * DMODEL, 0, (size_t)256 * DMODEL, (size_t)DMODEL * DMODEL, SEQ / 256);
            pg8::EpiSoftmax E{PM, DMODEL, (LAS float*)(ldsL + LDS_X_OFF)};
            for (int rp_ = 0; rp_ < ((PROBE_X2 & 16) ? 2 : 1); ++rp_)
            if (!(DBG_OFF & 4)) pg8::gemm_phase<pg8::EpiSoftmax, pg8::Order, true, true>(ldsL, g, S, E);
        } else if (st == 8) {
            pg8::Gemm g{XB, (const u16*)(wl + W_GU), DMODEL, DMODEL, DMODEL}; pg8::Order S; S.init(T / 256, 2 * DFF / 256, G, bx, (size_t)256 * DMODEL, 0, (size_t)256 * DMODEL, 0, 1);
            pg8::EpiSwiglu E{HF, DFF};
            for (int rp_ = 0; rp_ < ((PROBE_X2 & 8) ? 2 : 1); ++rp_)
            if (!(DBG_OFF & 8)) pg8::gemm_phase<pg8::EpiSwiglu, pg8::Order, true, true>(ldsL, g, S, E);
        } else {
            if (!(DBG_OFF & 256) && st == 0 && vcu < 16) {
                PHASE_IDS
                const int bh = vcu, s0 = tid * 32; const f32x4* src = (const f32x4*)(LF + (size_t)bh * SEQ + s0);
                f32x4 lv[8]; float sum = 0.f;
#pragma unroll
                for (int i = 0; i < 8; ++i) { lv[i] = src[i]; sum += (lv[i][0] + lv[i][1]) + (lv[i][2] + lv[i][3]); }
                LAS float* sh = (LAS float*)ldsL;
                sh[tid] = sum;
                __syncthreads();
                if (tid < 8) { float wt = 0.f; for (int i = 0; i < 64; ++i) wt += sh[64 * tid + i]; sh[512 + tid] = wt; }
                __syncthreads();
                float run = 0.f; for (int i = 0; i < wave; ++i) run += sh[512 + i];
                for (int i = 0; i < lane; ++i) run += sh[64 * wave + i];
                f32x4* dst = (f32x4*)(CS + (size_t)bh * SEQ + s0);
#pragma unroll
                for (int i = 0; i < 8; ++i) { f32x4 o; run += lv[i][0]; o[0] = run; run += lv[i][1]; o[1] = run; run += lv[i][2]; o[2] = run; run += lv[i][3]; o[3] = run; dst[i] = o; }
                __syncthreads();
            }
            const int njobs = (st == 0 && l == 0) ? 5 : (st == 3 && l == 0) ? 9 : 1;
            for (int j = 0; j < njobs; ++j) {
                pg8::Gemm g; pg8::Order S; pg8::EpiStore E;
                if (st == 0 && njobs == 5 && j < 4) {
                    const int ll = j >> 1; unsigned char* wll = ws + OFF_WT + (size_t)ll * WT_LAYER; const int c = (bx + G - 8 * j) % G;
                    if ((j & 1) == 0) { g = pg8::Gemm{MN, (const u16*)(wll + W_MKV), DMODEL, DMODEL, DMODEL}; S.init(2, 4, G, c, (size_t)256 * DMODEL, 0, (size_t)256 * DMODEL, 0, 1);
                        E = pg8::EpiStore{(u16*)(ws + OFF_KM + (size_t)ll * MiB), DMODEL}; }
                    else { g = pg8::Gemm{MN, (const u16*)(wll + W_MKV) + (size_t)DMODEL * DMODEL, DMODEL, DMODEL, DMODEL}; S.init(2, 4, G, c, (size_t)256 * DMODEL, 0, (size_t)256 * DMODEL, 0, 1);
                        E = pg8::EpiStore{(u16*)(ws + OFF_VM + (size_t)ll * MiB), DMODEL}; }
                } else if (st == 0) { g = pg8::Gemm{XB, (const u16*)(wl + W_QKV), DMODEL, DMODEL, DMODEL}; S.init(T / 256, 12, G, bx, (size_t)256 * DMODEL, 0, (size_t)256 * DMODEL, 0, 1); E = pg8::EpiStore{QKV, 3072}; }
                else if (st == 3 && njobs == 9 && j < 8) {
                    const int lb = j >> 1, ll = lb >> 1; unsigned char* wll = ws + OFF_WT + (size_t)ll * WT_LAYER; const int c = (bx + G - 16 * j) % G;
                    if ((j & 1) == 0) { g = pg8::Gemm{(const u16*)(ws + OFF_KM) + (size_t)lb * NMEM * DMODEL, (const u16*)(wll + W_MQ), 256, DMODEL, DMODEL}; S.init(4, 4, G, c, 256, 0, (size_t)256 * DMODEL, 256, 1);
                        E = pg8::EpiStore{(u16*)(ws + OFF_WQK) + (size_t)lb * DMODEL * DMODEL, DMODEL}; }
                    else { g = pg8::Gemm{(const u16*)(wll + W_MO), (const u16*)(ws + OFF_VM) + (size_t)lb * NMEM * DMODEL, 256, DMODEL, DMODEL}; S.init(4, 4, G, c, (size_t)256 * DMODEL, 256, 256, 0, 1);
                        E = pg8::EpiStore{(u16*)(ws + OFF_VWO) + (size_t)lb * DMODEL * DMODEL, DMODEL}; }
                }
                else if (st == 3) { g = pg8::Gemm{OB, (const u16*)(wl + W_OUT), DMODEL, DMODEL, DMODEL}; S.init(T / 256, 4, G, bx, (size_t)256 * DMODEL, 0, (size_t)256 * DMODEL, 0, 1); E = pg8::EpiStore{Yb, DMODEL, STAT}; }
                else if (st == 6) { g = pg8::Gemm{PM, (const u16*)(ws + OFF_VWO + (size_t)l * 4 * MiB), DMODEL, DMODEL, DMODEL}; S.init(T / 256, 4, G, bx, (size_t)256 * DMODEL, 0, (size_t)256 * DMODEL, (size_t)DMODEL * DMODEL, SEQ / 256); E = pg8::EpiStore{Yb, DMODEL}; }
                else { g = pg8::Gemm{HF, (const u16*)(wl + W_D), DFF, DFF, DFF}; S.init(T / 256, 4, G, bx, (size_t)256 * DFF, 0, (size_t)256 * DFF, 0, 1); E = pg8::EpiStore{Yb, DMODEL}; }
                for (int rp_ = 0; rp_ < ((PROBE_X2 & 4) ? 2 : 1); ++rp_)
                if (!(DBG_OFF & 16)) pg8::gemm_phase<pg8::EpiStore, pg8::Order, true, true>(ldsL, g, S, E);
            }
        }
        if (step != 21) xcd_barrier(bar);
#ifdef PROBE_SYNC
        xcd_barrier(bar); xcd_barrier(bar);
#endif
    }
}

extern "C" void kernel_launch(void* const* d_in, const int* in_sizes, int n_in, void* d_out, int out_size, void* d_ws, size_t ws_size, hipStream_t stream) {
    static int grid = 0;
    if (grid == 0) {
        if (n_in != 20 || in_sizes[0] != T * DMODEL || out_size != T * DMODEL || ws_size < WS_END) { fprintf(stderr, "kernel_launch: unexpected shapes (n_in %d, in0 %d, out %d, ws %zu)\n", n_in, n_in > 0 ? in_sizes[0] : -1, out_size, ws_size); grid = -1; return; }
        int dev = 0, cus = 0, per_cu = 0;
        if (hipGetDevice(&dev) != hipSuccess || hipDeviceGetAttribute(&cus, hipDeviceAttributeMultiprocessorCount, dev) != hipSuccess) { grid = -1; return; }
        if (hipFuncSetAttribute((const void*)fwd_kernel, hipFuncAttributeMaxDynamicSharedMemorySize, LDS_BYTES) != hipSuccess) { fprintf(stderr, "kernel_launch: hipFuncSetAttribute failed\n"); grid = -1; return; }
        if (hipOccupancyMaxActiveBlocksPerMultiprocessor(&per_cu, (const void*)fwd_kernel, 512, LDS_BYTES) != hipSuccess || per_cu < 1) { fprintf(stderr, "kernel_launch: occupancy query reports %d\n", per_cu); per_cu = 1; }
        (void)hipGetLastError();
        grid = cus * 1;
        while (grid > 16 && (T % (32 * grid)) != 0) --grid;
    }
    if (grid < 0) return;
    if (hipMemsetAsync((char*)d_ws + OFF_CTL, 0, CTL_BYTES, stream) != hipSuccess) { fprintf(stderr, "kernel_launch: hipMemsetAsync failed\n"); return; }
    Params p{};
    for (int i = 0; i < 20; ++i) p.in[i] = (const float*)d_in[i];
    p.out = (float*)d_out; p.ws = (unsigned char*)d_ws;
    void* args[] = {&p};
    const hipError_t e = hipLaunchCooperativeKernel((const void*)fwd_kernel, dim3(grid), dim3(512), args, LDS_BYTES, stream);
    if (e != hipSuccess) fprintf(stderr, "kernel_launch: cooperative launch failed: %s (grid %d)\n", hipGetErrorString(e), grid);
}
```

```cpp
#include <hip/hip_runtime.h>
#include <hip/hip_cooperative_groups.h>
#include <hip/hip_bf16.h>
#include <cstdio>
#include <cstdint>
#include <cmath>
namespace cg = cooperative_groups;
namespace pg8 {
#define PG8_LAS __attribute__((address_space(3)))
typedef unsigned short bf16_t;
typedef short bf16x8 __attribute__((ext_vector_type(8)));
typedef float f32x4 __attribute__((ext_vector_type(4)));
typedef unsigned u32x4 __attribute__((ext_vector_type(4)));
constexpr int BM = 256, BK = 64, HALF = 128, HTB = HALF * BK * 2  , STAGE_BYTES = 8 * HTB, NXCD = 8, WGM = 8;

__host__ __device__ __forceinline__ int lds_byte(int r, int c) { const int st = (r >> 4) * 2 + (c >> 5), rr = r & 15, cc = c & 31, ob = rr * 64 + cc * 2; return st * 1024 + (ob ^ (((ob >> 9) & 1) << 5)); }
__host__ __device__ __forceinline__ void stage_rc(int b, int& R, int& C) { const int st = b / 1024, sb = b % 1024, swz = sb ^ (((sb >> 9) & 1) << 5); R = (st >> 1) * 16 + swz / 64; C = (st & 1) * 32 + (swz % 64) / 2; }
__host__ __device__ __forceinline__ int perm32(int rho) { const int n = rho >> 4, i = rho & 15; return 8 * (i >> 2) + 4 * n + (i & 3); }

__device__ __forceinline__ void glds16s(const void* sbase, unsigned voff, unsigned lds_dst) {
    asm volatile("s_mov_b32 m0, %2\n\ts_nop 0\n\tglobal_load_lds_dwordx4 %0, %1" : : "v"(voff), "s"(sbase), "s"(lds_dst) : "memory"); }
struct Unit { int pm, pn; size_t ao, bo; };
struct Gemm { const bf16_t* A; const bf16_t* Bt; int K, lda, ldb; };

struct Order {
    int nM, nN, nwg, G, c, bdiv; size_t a_pm, a_pn, b_pn, b_pb;
    __device__ __forceinline__ void init(int nM_, int nN_, int G_, int c_, size_t a_pm_, size_t a_pn_, size_t b_pn_, size_t b_pb_, int bdiv_) {
        nM = nM_; nN = nN_; nwg = nM_ * nN_; G = G_; c = c_; a_pm = a_pm_; a_pn = a_pn_; b_pn = b_pn_; b_pb = b_pb_; bdiv = bdiv_; }
    __device__ __forceinline__ bool next(int i, Unit& u) const {
        const long L = (long)i * G + c; if (L >= nwg) return false;
        int wgid = (int)L; { const int q = nwg / NXCD, r = nwg % NXCD, xcd = wgid % NXCD, off = wgid / NXCD; wgid = (xcd < r ? xcd * (q + 1) : r * (q + 1) + (xcd - r) * q) + off; }
        const int nig = WGM * nN, gid = wgid / nig, fm = gid * WGM, gsz = (nM - fm) < WGM ? (nM - fm) : WGM;
        u.pm = fm + ((wgid % nig) % gsz); u.pn = (wgid % nig) / gsz;
        u.ao = (size_t)u.pm * a_pm + (size_t)u.pn * a_pn; u.bo = (size_t)u.pn * b_pn + (size_t)(u.pm / bdiv) * b_pb; return true;
    }
    __device__ __forceinline__ void a_ready(const Unit&) const {}
    __device__ __forceinline__ void done(const Unit&) const {}
};
__device__ __forceinline__ unsigned cvt_pk_bf16(float lo, float hi) { unsigned r; asm volatile("v_cvt_pk_bf16_f32 %0, %1, %2" : "=v"(r) : "v"(lo), "v"(hi)); return r; }
typedef float f32x2 __attribute__((ext_vector_type(2)));
template <int MASK> __device__ __forceinline__ float swz_xor(float v) { return __builtin_bit_cast(float, __builtin_amdgcn_ds_swizzle(__builtin_bit_cast(int, v), (MASK << 10) | 0x1f)); }
__device__ __forceinline__ void half_swap(float& a, float& b) { asm volatile("s_nop 1\n\tv_permlane32_swap_b32_e32 %0, %1\n\ts_nop 1" : "+v"(a), "+v"(b)); }
__device__ __forceinline__ float half_sum(float v) { float a = v, b = v; half_swap(a, b); return a + b; }
__device__ __forceinline__ float half_max(float v) { float a = v, b = v; half_swap(a, b); return fmaxf(a, b); }

struct EpiStore {
    static constexpr bool PERM = true, AFTER_DRAIN = false;
    bf16_t* O; int ldc; const float* stat;
    __device__ __forceinline__ static float rstd512(float s) { return 1.0f / sqrtf(s * (1.0f / 512.0f) + 1e-6f); }
    __device__ __forceinline__ void mid(f32x4 (&acc)[2][2][4][2], const Unit& u, int wr) const {
        int l_ = threadIdx.x; asm volatile("" : "+v"(l_)); const int fr = l_ & 15;
#pragma unroll
        for (int ai = 0; ai < 2; ++ai)
#pragma unroll
            for (int m = 0; m < 4; ++m) { const f32x2 sv = *(const f32x2*)(stat + (size_t)(u.pm * BM + wr * 64 + fr + ai * HALF + m * 16) * 2); const float f = rstd512(sv[0]) / rstd512(sv[1]);
#pragma unroll
                for (int bj = 0; bj < 2; ++bj) { acc[ai][bj][m][0] = acc[ai][bj][m][0] * f; acc[ai][bj][m][1] = acc[ai][bj][m][1] * f; } }
    }
    __device__ __forceinline__ void operator()(const f32x4 (&acc)[2][2][4][2], const Unit& u, int wr, int wc, int fr_, int fq_) const {
        int l_ = threadIdx.x; asm volatile("" : "+v"(l_)); const int fr = l_ & 15, fq = (l_ >> 4) & 3; (void)fr_; (void)fq_;
        const int row0 = u.pm * BM + wr * 64 + fr, col0 = u.pn * BM + wc * 32 + 8 * fq;
#pragma unroll
        for (int ai = 0; ai < 2; ++ai)
#pragma unroll
            for (int m = 0; m < 4; ++m) { bf16_t* rowp = O + (size_t)(row0 + ai * HALF + m * 16) * ldc + col0;
                float rs = 1.0f; if (stat) rs = rstd512(stat[(size_t)(row0 + ai * HALF + m * 16) * 2 + 1]);
#pragma unroll
                for (int bj = 0; bj < 2; ++bj) { const f32x4 v0 = acc[ai][bj][m][0] * rs, v1 = acc[ai][bj][m][1] * rs;
                    u32x4 w; w.x = cvt_pk_bf16(v0[0], v0[1]); w.y = cvt_pk_bf16(v0[2], v0[3]); w.z = cvt_pk_bf16(v1[0], v1[1]); w.w = cvt_pk_bf16(v1[2], v1[3]);
                    *(u32x4*)(rowp + bj * HALF) = w; } }
    }
};
struct EpiSwiglu {
    static constexpr bool PERM = true, AFTER_DRAIN = false; static constexpr const float* stat = nullptr;
    __device__ __forceinline__ void mid(f32x4 (&)[2][2][4][2], const Unit&, int) const {}
    bf16_t* O; int ldc;
    __device__ __forceinline__ static float silu_mul(float g, float u) { return g * __builtin_amdgcn_rcpf(1.0f + __builtin_amdgcn_exp2f(-1.4426950408889634f * g)) * u; }
    __device__ __forceinline__ void operator()(const f32x4 (&acc)[2][2][4][2], const Unit& u, int wr, int wc, int fr_, int fq_) const {
        int l_ = threadIdx.x; asm volatile("" : "+v"(l_)); const int fr = l_ & 15, fq = (l_ >> 4) & 3; (void)fr_; (void)fq_;
        const int row0 = u.pm * BM + wr * 64 + fr, col0 = u.pn * HALF + wc * 32 + 8 * fq;
#pragma unroll
        for (int ai = 0; ai < 2; ++ai)
#pragma unroll
            for (int m = 0; m < 4; ++m) { bf16_t* rowp = O + (size_t)(row0 + ai * HALF + m * 16) * ldc + col0;
                const f32x4 g0 = acc[ai][0][m][0], g1 = acc[ai][0][m][1], u0 = acc[ai][1][m][0], u1 = acc[ai][1][m][1];
                u32x4 w; w.x = cvt_pk_bf16(silu_mul(g0[0], u0[0]), silu_mul(g0[1], u0[1])); w.y = cvt_pk_bf16(silu_mul(g0[2], u0[2]), silu_mul(g0[3], u0[3]));
                w.z = cvt_pk_bf16(silu_mul(g1[0], u1[0]), silu_mul(g1[1], u1[1])); w.w = cvt_pk_bf16(silu_mul(g1[2], u1[2]), silu_mul(g1[3], u1[3]));
                *(u32x4*)rowp = w; }
    }
};
struct EpiSoftmax {
    static constexpr bool PERM = true, AFTER_DRAIN = false; static constexpr const float* stat = nullptr;
    __device__ __forceinline__ void mid(f32x4 (&)[2][2][4][2], const Unit&, int) const {}
    bf16_t* O; int ldc; PG8_LAS float* X;
    __device__ __forceinline__ void operator()(f32x4 (&acc)[2][2][4][2], const Unit& u, int wr, int wc, int fr_, int fq_) const {
        int l_ = threadIdx.x; asm volatile("" : "+v"(l_)); const int fr = l_ & 15, fq = (l_ >> 4) & 3; (void)fr_; (void)fq_;
        float mx[2][4];
        int xw = ((wr * 64 + fr) * 4 + wc) * 2, xr = (wr * 64 + fr) * 8; asm volatile("" : "+v"(xw), "+v"(xr));
#pragma unroll
        for (int ai = 0; ai < 2; ++ai)
#pragma unroll
            for (int m = 0; m < 4; ++m) {
                float mm = -3.0e38f;
#pragma unroll
                for (int bj = 0; bj < 2; ++bj)
#pragma unroll
                    for (int n = 0; n < 2; ++n) { const f32x4 v = acc[ai][bj][m][n]; mm = fmaxf(mm, fmaxf(fmaxf(v[0], v[1]), fmaxf(v[2], v[3]))); }
                mm = fmaxf(mm, swz_xor<16>(mm)); mm = half_max(mm);
                float s = 0.f;
#pragma unroll
                for (int bj = 0; bj < 2; ++bj)
#pragma unroll
                    for (int n = 0; n < 2; ++n) { f32x4 v = acc[ai][bj][m][n];
                        v[0] = __builtin_amdgcn_exp2f(v[0] - mm); v[1] = __builtin_amdgcn_exp2f(v[1] - mm); v[2] = __builtin_amdgcn_exp2f(v[2] - mm); v[3] = __builtin_amdgcn_exp2f(v[3] - mm);
                        s += (v[0] + v[1]) + (v[2] + v[3]); acc[ai][bj][m][n] = v; }
                s += swz_xor<16>(s); s = half_sum(s);
                mx[ai][m] = mm;
                if (fq == 0) { PG8_LAS float* xp = X + xw + (ai * HALF + m * 16) * 8; xp[0] = mm; xp[1] = s; }
                asm volatile("" ::: "memory"); __builtin_amdgcn_sched_barrier(0);
            }
        asm volatile("s_waitcnt lgkmcnt(0)" ::: "memory"); __builtin_amdgcn_s_barrier(); asm volatile("" ::: "memory");
        const int row0 = u.pm * BM + wr * 64 + fr, col0 = u.pn * BM + wc * 32 + 8 * fq;
#pragma unroll
        for (int ai = 0; ai < 2; ++ai)
#pragma unroll
            for (int m = 0; m < 4; ++m) {
                const f32x4 x0 = *(const PG8_LAS f32x4*)(X + xr + (ai * HALF + m * 16) * 8), x1 = *(const PG8_LAS f32x4*)(X + xr + (ai * HALF + m * 16) * 8 + 4);
                const float M = fmaxf(fmaxf(x0[0], x0[2]), fmaxf(x1[0], x1[2]));
                const float L = x0[1] * __builtin_amdgcn_exp2f(x0[0] - M) + x0[3] * __builtin_amdgcn_exp2f(x0[2] - M) + x1[1] * __builtin_amdgcn_exp2f(x1[0] - M) + x1[3] * __builtin_amdgcn_exp2f(x1[2] - M);
                const float f = __builtin_amdgcn_exp2f(mx[ai][m] - M) / L;
                bf16_t* rowp = O + (size_t)(row0 + ai * HALF + m * 16) * ldc + col0;
#pragma unroll
                for (int bj = 0; bj < 2; ++bj) { const f32x4 v0 = acc[ai][bj][m][0] * f, v1 = acc[ai][bj][m][1] * f;
                    u32x4 w; w.x = cvt_pk_bf16(v0[0], v0[1]); w.y = cvt_pk_bf16(v0[2], v0[3]); w.z = cvt_pk_bf16(v1[0], v1[1]); w.w = cvt_pk_bf16(v1[2], v1[3]);
                    *(u32x4*)(rowp + bj * HALF) = w; }
                asm volatile("" ::: "memory"); __builtin_amdgcn_sched_barrier(0); }
        asm volatile("s_waitcnt lgkmcnt(0)" ::: "memory"); __builtin_amdgcn_s_barrier(); asm volatile("" ::: "memory");
    }
};

template <class Epi, class Sched, bool ALIGN_EPI = false, bool SP2 = false>
__device__ __forceinline__ void gemm_phase(PG8_LAS unsigned char* lds, const Gemm g, const Sched& S, const Epi& E) {
    int tid_ = threadIdx.x; asm volatile("" : "+v"(tid_));
    const int tid = tid_, wid = __builtin_amdgcn_readfirstlane(tid >> 6), lane = tid & 63, wr = wid >> 2, wc = wid & 3, fr = lane & 15, fq = lane >> 4;
    const int K = g.K, nt = K / BK;
    unsigned voffA[2], voffB[2];
#pragma unroll
    for (int i = 0; i < 2; ++i) { int R, C; stage_rc(tid * 16 + i * 8192, R, C); const int Rb = Epi::PERM ? ((R & ~31) + perm32(R & 31)) : R;
        voffA[i] = (unsigned)(R * g.lda + C) * 2u; voffB[i] = (unsigned)(Rb * g.ldb + C) * 2u; }
    const size_t kstep = (size_t)(BK * 2);
    const size_t hstepA = (size_t)HALF * g.lda * 2, hstepB = (size_t)HALF * g.ldb * 2;
    const unsigned ldsbase = (unsigned)(uintptr_t)lds;
    const unsigned ldsw = (unsigned)wid * 1024u;
    const int aoff = lds_byte(wr * 64 + fr, fq * 8), boff = lds_byte(wc * 32 + fr, fq * 8);
#define PG8_SA(b, h) (((b) * 2 + (h)) * HTB)
#define PG8_SB(b, h) ((4 + (b) * 2 + (h)) * HTB)
#define PG8_STAGE(bufoff, gbase, voff) do { _Pragma("unroll") for (int _i = 0; _i < 2; ++_i) \
        glds16s((const void*)(gbase), (voff)[_i], (unsigned)__builtin_amdgcn_readfirstlane((int)(ldsbase + (unsigned)(bufoff) + ldsw + (unsigned)(_i * 8192)))); } while (0)
#define PG8_LDA(dst, b, h) do { _Pragma("unroll") for (int m = 0; m < 4; ++m) _Pragma("unroll") for (int k = 0; k < 2; ++k) dst[m][k] = *(const PG8_LAS bf16x8*)(lds + PG8_SA(b, h) + aoff + m * 2048 + k * 1024); } while (0)
#define PG8_LDB(dst, b, h) do { _Pragma("unroll") for (int n = 0; n < 2; ++n) _Pragma("unroll") for (int k = 0; k < 2; ++k) dst[n][k] = *(const PG8_LAS bf16x8*)(lds + PG8_SB(b, h) + boff + n * 2048 + k * 1024); } while (0)
#define PG8_MMA(ai, bj, At, Bt) do { __builtin_amdgcn_s_setprio(1); _Pragma("unroll") for (int m = 0; m < 4; ++m) _Pragma("unroll") for (int n = 0; n < 2; ++n) _Pragma("unroll") for (int k = 0; k < 2; ++k) \
        acc[ai][bj][m][n] = __builtin_amdgcn_mfma_f32_16x16x32_bf16(Bt[n][k], At[m][k], acc[ai][bj][m][n], 0, 0, 0); __builtin_amdgcn_s_setprio(0); } while (0)
#define PG8_WAIT_V(n) asm volatile("s_waitcnt vmcnt(" #n ")" ::: "memory")
#define PG8_WAIT_L(n) asm volatile("s_waitcnt lgkmcnt(" #n ")" ::: "memory")
#define PG8_BAR __builtin_amdgcn_s_barrier()
#define PG8_SCHED __builtin_amdgcn_sched_barrier(0)
    Unit cur, nxt; int ui = 0;
    if (!S.next(0, cur)) return;
    f32x4 acc[2][2][4][2];
#pragma unroll
    for (int a = 0; a < 2; ++a)
#pragma unroll
        for (int b = 0; b < 2; ++b)
#pragma unroll
            for (int m = 0; m < 4; ++m)
#pragma unroll
                for (int n = 0; n < 2; ++n) acc[a][b][m][n] = (f32x4){0.f, 0.f, 0.f, 0.f};
    bf16x8 At[4][2], B0[2][2], B1[2][2];
    const char* cA = (const char*)g.A + cur.ao * 2; const char* cB = (const char*)g.Bt + cur.bo * 2;
    S.a_ready(cur);
    if constexpr (SP2) {
        PG8_STAGE(PG8_SB(0, 0), cB, voffB); PG8_STAGE(PG8_SB(0, 1), cB + hstepB, voffB); PG8_STAGE(PG8_SA(0, 0), cA, voffA); PG8_STAGE(PG8_SA(0, 1), cA + hstepA, voffA);
        if (wr == 1) PG8_BAR;
        PG8_WAIT_V(2); PG8_BAR;
        PG8_STAGE(PG8_SB(1, 0), cB + kstep, voffB); PG8_STAGE(PG8_SA(1, 0), cA + kstep, voffA); PG8_STAGE(PG8_SB(1, 1), cB + hstepB + kstep, voffB);
        PG8_WAIT_V(6); PG8_BAR;
    } else {
        PG8_STAGE(PG8_SB(0, 0), cB, voffB); PG8_STAGE(PG8_SA(0, 0), cA, voffA); PG8_STAGE(PG8_SB(0, 1), cB + hstepB, voffB); PG8_STAGE(PG8_SA(0, 1), cA + hstepA, voffA);
        if (wr == 1) PG8_BAR;
        PG8_WAIT_V(4); PG8_BAR;
        PG8_STAGE(PG8_SB(1, 0), cB + kstep, voffB); PG8_STAGE(PG8_SA(1, 0), cA + kstep, voffA); PG8_STAGE(PG8_SB(1, 1), cB + hstepB + kstep, voffB);
        PG8_WAIT_V(6); PG8_BAR;
    }
    for (;;) {
        const bool has_next = S.next(ui + 1, nxt);
        const char* nA = has_next ? (const char*)g.A + nxt.ao * 2 : cA; const char* nB = has_next ? (const char*)g.Bt + nxt.bo * 2 : cB;
        for (int t = 0; t < nt; t += 2) {
            if (E.stat != nullptr && t == (nt >> 1)) E.mid(acc, cur, wr);
            const bool last = (t == nt - 2);
            const char* a1 = cA + (size_t)(t + 1) * kstep;
            const char* a2 = last ? nA : cA + (size_t)(t + 2) * kstep; const char* b2 = last ? nB : cB + (size_t)(t + 2) * kstep;
            const char* a3 = a2 + kstep; const char* b3 = b2 + kstep;
            if (last && has_next) S.a_ready(nxt);
            if constexpr (SP2) {
            PG8_LDB(B0, 0, 0); PG8_LDB(B1, 0, 1); PG8_SCHED; PG8_LDA(At, 0, 0); PG8_STAGE(PG8_SA(1, 1), a1 + hstepA, voffA);
            PG8_WAIT_V(8); PG8_WAIT_L(0); PG8_BAR; PG8_MMA(0, 0, At, B0); PG8_MMA(0, 1, At, B1); PG8_BAR; PG8_SCHED;
            PG8_LDA(At, 0, 1); PG8_STAGE(PG8_SB(0, 0), b2, voffB); PG8_STAGE(PG8_SB(0, 1), b2 + hstepB, voffB); PG8_STAGE(PG8_SA(0, 0), a2, voffA);
            PG8_WAIT_V(8); PG8_WAIT_L(0); PG8_BAR; PG8_MMA(1, 0, At, B0); PG8_MMA(1, 1, At, B1); PG8_BAR; PG8_SCHED;
            PG8_LDB(B0, 1, 0); PG8_LDB(B1, 1, 1); PG8_SCHED; PG8_LDA(At, 1, 0); PG8_STAGE(PG8_SA(0, 1), a2 + hstepA, voffA);
            PG8_WAIT_V(8); PG8_WAIT_L(0); PG8_BAR; PG8_MMA(0, 0, At, B0); PG8_MMA(0, 1, At, B1); PG8_BAR; PG8_SCHED;
            PG8_LDA(At, 1, 1); PG8_STAGE(PG8_SB(1, 0), b3, voffB); PG8_STAGE(PG8_SB(1, 1), b3 + hstepB, voffB); PG8_STAGE(PG8_SA(1, 0), a3, voffA);
            PG8_WAIT_V(8); PG8_WAIT_L(0); PG8_BAR; PG8_MMA(1, 0, At, B0); PG8_MMA(1, 1, At, B1); PG8_BAR; PG8_SCHED;
            } else {
            PG8_LDB(B0, 0, 0); PG8_SCHED; PG8_LDA(At, 0, 0); PG8_STAGE(PG8_SA(1, 1), a1 + hstepA, voffA);
            PG8_WAIT_L(8); PG8_BAR; PG8_WAIT_L(0); PG8_MMA(0, 0, At, B0); PG8_BAR; PG8_SCHED;
            PG8_LDB(B1, 0, 1); PG8_STAGE(PG8_SB(0, 0), b2, voffB);
            PG8_BAR; PG8_WAIT_L(0); PG8_MMA(0, 1, At, B1); PG8_BAR;
            PG8_LDA(At, 0, 1); PG8_STAGE(PG8_SA(0, 0), a2, voffA);
            PG8_BAR; PG8_WAIT_L(0); PG8_MMA(1, 0, At, B0); PG8_BAR; PG8_SCHED;
            PG8_STAGE(PG8_SB(0, 1), b2 + hstepB, voffB);
            PG8_WAIT_V(6); PG8_BAR; PG8_MMA(1, 1, At, B1); PG8_BAR;
            PG8_LDB(B0, 1, 0); PG8_SCHED; PG8_LDA(At, 1, 0); PG8_STAGE(PG8_SA(0, 1), a2 + hstepA, voffA);
            PG8_WAIT_L(8); PG8_BAR; PG8_WAIT_L(0); PG8_MMA(0, 0, At, B0); PG8_BAR; PG8_SCHED;
            PG8_LDB(B1, 1, 1); PG8_STAGE(PG8_SB(1, 0), b3, voffB);
            PG8_BAR; PG8_WAIT_L(0); PG8_MMA(0, 1, At, B1); PG8_BAR;
            PG8_LDA(At, 1, 1); PG8_STAGE(PG8_SA(1, 0), a3, voffA);
            PG8_BAR; PG8_WAIT_L(0); PG8_MMA(1, 0, At, B0); PG8_BAR; PG8_SCHED;
            PG8_STAGE(PG8_SB(1, 1), b3 + hstepB, voffB);
            PG8_WAIT_V(6); PG8_BAR; PG8_MMA(1, 1, At, B1); PG8_BAR;
            }
        }
        if constexpr (ALIGN_EPI) { if (wr == 0) PG8_BAR; }
        if constexpr (!Epi::AFTER_DRAIN) { E(acc, cur, wr, wc, fr, fq); S.done(cur); }
        if (!has_next) break;
#pragma unroll
        for (int a = 0; a < 2; ++a)
#pragma unroll
            for (int b = 0; b < 2; ++b)
#pragma unroll
                for (int m = 0; m < 4; ++m)
#pragma unroll
                    for (int n = 0; n < 2; ++n) acc[a][b][m][n] = (f32x4){0.f, 0.f, 0.f, 0.f};
        cur = nxt; cA = nA; cB = nB; ++ui;
        if constexpr (ALIGN_EPI) { if (wr == 1) PG8_BAR; }
    }
    PG8_WAIT_V(0);
    if constexpr (!ALIGN_EPI) { if (wr == 0) PG8_BAR; }
    PG8_BAR;
    if constexpr (Epi::AFTER_DRAIN) { E.fused(acc, cur, wr, wc, fr, fq, lds, wid, lane); S.done(cur); }
#undef PG8_SA
#undef PG8_SB
#undef PG8_STAGE
#undef PG8_LDA
#undef PG8_LDB
#undef PG8_MMA
#undef PG8_WAIT_V
#undef PG8_WAIT_L
#undef PG8_BAR
#undef PG8_SCHED
}
}

#include <hip/hip_bf16.h>
#include <cmath>
namespace attn_body {
using bf16=__hip_bfloat16;
using bf16x8=__attribute__((ext_vector_type(8)))short;
using s16x4=__attribute__((ext_vector_type(4)))short;
using f32x16=__attribute__((ext_vector_type(16)))float;
using u32x4=__attribute__((ext_vector_type(4)))unsigned;
constexpr int SEQ=16384,D=64,PQ=3072,PO=1024;
constexpr int NW=8,QBLK=32,QB=QBLK*NW,KVBLK=64,NQB=SEQ/QB;
constexpr int ATTN_UNIT_ROWS=QB;
__device__ __forceinline__ int crow(int r,int hi){return (r&3)+8*(r>>2)+4*hi;}
#define SBAR() __builtin_amdgcn_sched_barrier(0)
__device__ __forceinline__ void cmask(f32x16&p0,f32x16&p1,int jb,int qrel,int hi){
  const float NEG=-INFINITY; int kb=64*jb+4*hi;
  #pragma unroll
  for(int r=0;r<16;++r){int kv=kb+(r&3)+8*(r>>2); if(kv>qrel)p0[r]=NEG; if(kv+32>qrel)p1[r]=NEG;}
}

__device__ __forceinline__ unsigned f2bf_rne(float f){unsigned u=__builtin_bit_cast(unsigned,f);return (u+0x7fffu+((u>>16)&1u))>>16;}
__device__ __forceinline__ unsigned pack_hilo(float v){const unsigned hb=f2bf_rne(v);const float hf=__builtin_bit_cast(float,hb<<16);const unsigned lb=f2bf_rne(v-hf);return hb|(lb<<16);}
typedef float f32x4v __attribute__((ext_vector_type(4)));
__device__ __forceinline__ void cbias(f32x16&p0,f32x16&p1,int dj,int qloc,int hi,const __attribute__((address_space(3))) float*E){
  const int j0=254-(qloc+64*dj+63-4*hi), a=j0&3;
  const __attribute__((address_space(3))) f32x4v* ep=(const __attribute__((address_space(3))) f32x4v*)(E+a*260+(j0&~3));
  #pragma unroll
  for(int g=0;g<4;++g){ const f32x4v v0=ep[2*g], v1=ep[2*g+8];
    p0[4*g]+=v0[0];p0[4*g+1]+=v0[1];p0[4*g+2]+=v0[2];p0[4*g+3]+=v0[3]; p1[4*g]+=v1[0];p1[4*g+1]+=v1[1];p1[4*g+2]+=v1[2];p1[4*g+3]+=v1[3]; }
}
constexpr int NSLOT=3, SLOTB=8192;
constexpr int LDS_K=0, LDS_V=NSLOT*SLOTB, LDS_WS=2*NSLOT*SLOTB, LDS_OST=LDS_WS+NW*64*4, LDS_CB=LDS_OST+NW*4096, LDS_BYTES=LDS_CB+65536;
constexpr float C2=0.125f*1.4426950408889634f;
__device__ __forceinline__ void glds16(const void*gsrc,unsigned lds_dst){unsigned keep;
  asm volatile("s_mov_b32 %0, m0\n\ts_mov_b32 m0, %2\n\ts_nop 0\n\tglobal_load_lds_dwordx4 %1, off\n\ts_mov_b32 m0, %0":"=&s"(keep):"v"(gsrc),"s"(lds_dst):"memory");}
__device__ __forceinline__ void glds16sa(const void*sbase,unsigned voff,unsigned lds_dst){unsigned keep;
  asm volatile("s_mov_b32 %0, m0\n\ts_mov_b32 m0, %3\n\ts_nop 0\n\tglobal_load_lds_dwordx4 %1, %2\n\ts_mov_b32 m0, %0":"=&s"(keep):"v"(voff),"s"(sbase),"s"(lds_dst):"memory");}
template<int MASK> __device__ __forceinline__ float swzx(float v){return __builtin_bit_cast(float,__builtin_amdgcn_ds_swizzle(__builtin_bit_cast(int,v),(MASK<<10)|0x1f));}
__device__ __forceinline__ float max3f(float a,float b,float c){float r;asm("v_max3_f32 %0, %1, %2, %3":"=v"(r):"v"(a),"v"(b),"v"(c));return r;}
__device__ __forceinline__ float max2f(float a,float b){float r;asm("v_max_f32_e32 %0, %1, %2":"=v"(r):"v"(a),"v"(b));return r;}
__device__ __forceinline__ float fadd_s(float a,float b){float r;asm("v_add_f32_e32 %0, %1, %2":"=v"(r):"v"(a),"v"(b));return r;}
__device__ __forceinline__ float fsub_s(float a,float b){float r;asm("v_sub_f32_e32 %0, %1, %2":"=v"(r):"v"(a),"v"(b));return r;}
typedef float f32x2_t __attribute__((ext_vector_type(2))); typedef __bf16 bf16x2_t __attribute__((ext_vector_type(2)));
__device__ __forceinline__ unsigned cvtpk_s(float lo,float hi){f32x2_t v={lo,hi};bf16x2_t b=__builtin_convertvector(v,bf16x2_t);return __builtin_bit_cast(unsigned,b);}
#define WAIT_BAR(N) asm volatile("s_waitcnt vmcnt(" #N ") lgkmcnt(0)\n\ts_barrier":::"memory")

__device__ __forceinline__ void qkt(f32x16&p0,f32x16&p1,const char*Kslot,const bf16x8*qr,const f32x16&c0i,const f32x16&c1i,int r32,int hi){
  const char*kb=Kslot+hi*1024+r32*16;
  #pragma unroll
  for(int d0=0;d0<4;++d0){
    const bf16x8 b0=*reinterpret_cast<const bf16x8*>(kb+d0*2048);
    const bf16x8 b1=*reinterpret_cast<const bf16x8*>(kb+d0*2048+512);
    if(d0==0){p0=__builtin_amdgcn_mfma_f32_32x32x16_bf16(b0,qr[0],c0i,0,0,0);p1=__builtin_amdgcn_mfma_f32_32x32x16_bf16(b1,qr[0],c1i,0,0,0);}
    else{p0=__builtin_amdgcn_mfma_f32_32x32x16_bf16(b0,qr[d0],p0,0,0,0);p1=__builtin_amdgcn_mfma_f32_32x32x16_bf16(b1,qr[d0],p1,0,0,0);}}
}
typedef __attribute__((address_space(3))) const char* lds_cptr;
typedef short v4i16_t __attribute__((ext_vector_type(4)));
__device__ __forceinline__ void kload8(bf16x8*kf,lds_cptr kp){
  kf[0]=*(const __attribute__((address_space(3))) bf16x8*)(kp);      kf[1]=*(const __attribute__((address_space(3))) bf16x8*)(kp+512);
  kf[2]=*(const __attribute__((address_space(3))) bf16x8*)(kp+2048); kf[3]=*(const __attribute__((address_space(3))) bf16x8*)(kp+2560);
  kf[4]=*(const __attribute__((address_space(3))) bf16x8*)(kp+4096); kf[5]=*(const __attribute__((address_space(3))) bf16x8*)(kp+4608);
  kf[6]=*(const __attribute__((address_space(3))) bf16x8*)(kp+6144); kf[7]=*(const __attribute__((address_space(3))) bf16x8*)(kp+6656);
}
__device__ __forceinline__ void kload2(bf16x8*kf,lds_cptr kp,int j){ kf[2*j]=*(const __attribute__((address_space(3))) bf16x8*)(kp+j*2048); kf[2*j+1]=*(const __attribute__((address_space(3))) bf16x8*)(kp+j*2048+512); }
__device__ __forceinline__ s16x4 vtr(lds_cptr p){ return __builtin_bit_cast(s16x4,__builtin_amdgcn_ds_read_tr16_b64_v4i16((__attribute__((address_space(3))) v4i16_t*)p)); }
__device__ __forceinline__ float rowmax(const f32x16&p0,const f32x16&p1){
  float a=max3f(p0[0],p0[1],p1[0]),b=max3f(p0[2],p0[3],p1[1]);a=max3f(a,p1[2],p1[3]);
  #pragma unroll
  for(int r=4;r<16;r+=4){a=max3f(a,p0[r],p0[r+1]);b=max3f(b,p0[r+2],p0[r+3]);a=max3f(a,p1[r],p1[r+1]);b=max3f(b,p1[r+2],p1[r+3]);}
  const float m=max2f(a,b);
  auto rr=__builtin_amdgcn_permlane32_swap(__float_as_uint(m),__float_as_uint(m),false,false);
  return max2f(__uint_as_float(rr[0]),__uint_as_float(rr[1]));
}
__device__ __forceinline__ void pv(f32x16*o,int vb,bf16x8 pa0,bf16x8 pa1,bf16x8 pa2,bf16x8 pa3){
  #pragma unroll
  for(int d0=0;d0<2;++d0){s16x4 lo[4],hi[4];
    #pragma unroll
    for(int ks=0;ks<4;++ks){
      asm volatile("ds_read_b64_tr_b16 %0,%1 offset:%c2":"=&v"(lo[ks]):"v"(vb),"i"(d0*4096+ks*1024):"memory");
      asm volatile("ds_read_b64_tr_b16 %0,%1 offset:%c2":"=&v"(hi[ks]):"v"(vb),"i"(d0*4096+ks*1024+512):"memory");}
    asm volatile("s_waitcnt lgkmcnt(0)":::"memory");SBAR();
    #define PK(k) (bf16x8){lo[k][0],lo[k][1],lo[k][2],lo[k][3],hi[k][0],hi[k][1],hi[k][2],hi[k][3]}
    o[d0]=__builtin_amdgcn_mfma_f32_32x32x16_bf16(pa0,PK(0),o[d0],0,0,0);
    o[d0]=__builtin_amdgcn_mfma_f32_32x32x16_bf16(pa1,PK(1),o[d0],0,0,0);
    o[d0]=__builtin_amdgcn_mfma_f32_32x32x16_bf16(pa2,PK(2),o[d0],0,0,0);
    o[d0]=__builtin_amdgcn_mfma_f32_32x32x16_bf16(pa3,PK(3),o[d0],0,0,0);
    #undef PK
  }
}

#ifndef ATTN_STORE16
#define ATTN_STORE16(p,v) (*(u32x4*)(p)=(v))
#endif
template<int MODE,int THRL> __device__ __forceinline__ void attn_unit(int b,int h,int qb,const bf16*Q,const bf16*__restrict__ K,const bf16*__restrict__ V,bf16*O,char*shm,const float*aux,float*stat){
  int tid_=threadIdx.x; asm volatile("":"+v"(tid_));
  const int tid=tid_,lane=tid&63,r32=lane&31,hi=lane>>5; const int wid=__builtin_amdgcn_readfirstlane(tid>>6);
  const long rowbase=(long)b*SEQ; const int q0=qb*QB;
  const int t0=(MODE==1)?((4*qb-8)>0?(4*qb-8):0):0;
  const bf16*Qw=Q+(rowbase+q0+wid*QBLK)*PQ+h*D;
  const bf16*Kh=K+(rowbase+(long)t0*KVBLK)*PQ+h*D,*Vh=V+(rowbase+(long)t0*KVBLK)*PQ+h*D;
  const unsigned lds0=(unsigned)(uintptr_t)shm;
  float*wsf=(float*)(shm+LDS_WS)+wid*64;
  const unsigned koff=(unsigned)((lane*PQ+wid*8)*2);
  const unsigned voff=(unsigned)(((16*(wid&3)+(lane>>2))*PQ+(wid>>2)*32+(lane&3)*8)*2);
  const unsigned kdst=lds0+LDS_K+wid*1024, vdst=lds0+LDS_V+wid*1024;
  #define DMA_K(t,slot) glds16sa(Kh+(long)(t)*KVBLK*PQ,koff,(unsigned)__builtin_amdgcn_readfirstlane(kdst+(slot)))
  #define DMA_V(t,slot) glds16sa(Vh+(long)(t)*KVBLK*PQ,voff,(unsigned)__builtin_amdgcn_readfirstlane(vdst+(slot)))
  const int vb0=(int)(lds0+LDS_V)+((lane>>4)&1)*32+(lane&3)*8+(4*hi+((lane&15)>>2))*64;
  const char*Kbase=shm+LDS_K; bf16x8 kf[8];
  const lds_cptr shm3=(lds_cptr)shm; const lds_cptr kp0=shm3+LDS_K+hi*1024+r32*16; const lds_cptr vp0=shm3+LDS_V+((lane>>4)&1)*32+(lane&3)*8+(4*hi+((lane&15)>>2))*64;
  const int NT=(q0+QB)/KVBLK-t0;
  __attribute__((address_space(3))) unsigned* CBt=(__attribute__((address_space(3))) unsigned*)(shm3+LDS_CB);
  __attribute__((address_space(3))) float* RBt=(__attribute__((address_space(3))) float*)(shm3+LDS_CB);
  const int cw=4*qb+(wid>>1), qloc=32*(wid&1)+r32; unsigned pkfar=0u;
  if constexpr(MODE==0){ const float cref=aux[q0];
    for(int s0_=0;s0_<q0+QB;s0_+=8*NW*64){ float cv_[8];
      _Pragma("unroll") for(int j_=0;j_<8;++j_){ const int s_=s0_+j_*NW*64+tid; cv_[j_]=(s_<q0+QB)?aux[s_]:0.f; }
      _Pragma("unroll") for(int j_=0;j_<8;++j_){ const int s_=s0_+j_*NW*64+tid; if(s_<q0+QB)CBt[s_]=pack_hilo((cref-cv_[j_])*1.4426950408889634f); } } }
  else { _Pragma("unroll") for(int k_=0;k_<3;++k_){ const int idx_=tid+NW*64*k_; if(idx_<1040){ const int a_=idx_/260, j_=idx_-260*a_, i_=254-(j_+a_); RBt[idx_]=(i_<0)?0.f:aux[i_>191?191:i_]*1.4426950408889634f; } }
    pkfar=pack_hilo(aux[191]*1.4426950408889634f); }
  u32x4 qfw={hi==0?0x3F803F80u:0u,0u,0u,0u};
  u32x4 kbw0={0u,0x3F803F80u,0x00003F80u,0u},kbw1={0u,0x3F803F80u,0x00003F80u,0u};
  #define QF __builtin_bit_cast(bf16x8,qfw)
  #define KBF(w) __builtin_bit_cast(bf16x8,w)
  #define wb0 kbw0
  #define wb1 kbw1
  #define SETQF() do{ const float nm_=-mhat; const unsigned h_=f2bf_rne(nm_); const float r1_=nm_-__builtin_bit_cast(float,h_<<16); const unsigned m_=f2bf_rne(r1_); \
      const float r2_=r1_-__builtin_bit_cast(float,m_<<16); const unsigned l_=f2bf_rne(r2_); qfw[1]=hi==0?(h_|(m_<<16)):0u; qfw[2]=hi==0?l_:0u; }while(0)
  #define LOADB(t) do{ if constexpr(MODE==0){ kbw0[0]=CBt[64*(t)+r32]; kbw1[0]=CBt[64*(t)+32+r32]; } else { const int dj_=cw-(t0+(t)); const unsigned w_=(dj_<0||dj_>8)?0xC4FAu:(dj_>=3?pkfar:0u); kbw0[0]=w_; kbw1[0]=w_; } }while(0)
  const f32x16 zero16=f32x16{};
  DMA_K(0,0);DMA_V(0,0);DMA_K(1,SLOTB);
  bf16x8 qr[4];
  #pragma unroll
  for(int d0=0;d0<4;++d0)qr[d0]=*reinterpret_cast<const bf16x8*>(&Qw[(long)r32*PQ+d0*16+hi*8]);
  float mhat=(MODE==0)?((aux[q0]-aux[q0+wid*QBLK+r32])*1.4426950408889634f+12.0f):8.0f,l_reg=0.f;f32x16 o[2];o[0]=f32x16{};o[1]=f32x16{};
  SETQF();
  const int qrel=wid*QBLK+r32;
  #define CMASK(P0,P1,t) do{ if constexpr(MODE==0){int jb_=(t)-(NT-4); if(jb_>=0)cmask(P0,P1,jb_,qrel,hi);} else {const int dq_=cw-(t0+(t)); if(dq_>=0&&dq_<=2)cbias(P0,P1,dq_,qloc,hi,RBt);} }while(0)
  bool resc=false;
  #define START(P0,P1) do{ const float rm=rowmax(P0,P1); resc=false; \
    { const float dl=__builtin_fmaxf(rm,0.f); mhat=fadd_s(mhat,dl); \
      _Pragma("unroll") for(int r=0;r<16;++r){P0[r]=fsub_s(P0[r],dl);P1[r]=fsub_s(P1[r],dl);} \
      SETQF(); } \
    _Pragma("unroll") for(int r=0;r<16;++r)P0[r]=__builtin_amdgcn_exp2f(P0[r]); }while(0)
  #define RESC() do{ if(resc){ asm volatile("s_waitcnt lgkmcnt(0)":::"memory"); \
      _Pragma("unroll") for(int d_=0;d_<2;++d_) _Pragma("unroll") for(int r=0;r<16;++r)o[d_][r]*=wsf[crow(r,hi)]; } }while(0)
  f32x16 pA0,pA1,pB0,pB1;
  int sl_prev=0,sl_cur=0,sl_next=SLOTB;
  #define ROT() do{sl_prev=sl_cur;sl_cur=sl_next;sl_next=(sl_next==(NSLOT-1)*SLOTB)?0:sl_next+SLOTB;}while(0)
  DMA_K(2,2*SLOTB);
  WAIT_BAR(3);
  LOADB(0);
  { const f32x16 cb0=__builtin_amdgcn_mfma_f32_32x32x16_bf16(KBF(wb0),QF,zero16,0,0,0), cb1=__builtin_amdgcn_mfma_f32_32x32x16_bf16(KBF(wb1),QF,zero16,0,0,0);
    qkt(pA0,pA1,Kbase,qr,cb0,cb1,r32,hi); }
  LOADB(1);
  asm volatile("s_nop 15\n\ts_nop 7":"+v"(pA0),"+v"(pA1));CMASK(pA0,pA1,0);
  START(pA0,pA1);
  _Pragma("unroll") for(int r=0;r<16;++r)pA1[r]=__builtin_amdgcn_exp2f(pA1[r]);
  WAIT_BAR(0);
  DMA_K(3,0);DMA_V(1,SLOTB);
  ROT();
  kload8(kf,kp0+sl_cur);
  WAIT_BAR(2);
  s16x4 vlo[8],vhi[8]; u32x4 pw0,pw1,pw2,pw3;
  #define PKW(P,B) cvtpk_s(P[B],P[B+1])
  #define PAF(k) __builtin_bit_cast(bf16x8,pw##k)
  #define VFR(i) (bf16x8){vlo[i][0],vlo[i][1],vlo[i][2],vlo[i][3],vhi[i][0],vhi[i][1],vhi[i][2],vhi[i][3]}
  #define PIN(x) asm volatile("":"+v"(x))
  #define MX3(a,b,c) __builtin_fmaxf(__builtin_fmaxf((a),(b)),(c))
  #define GAPA(MF,A0,A1,A2,A3,W0,W1,PW) do{ MF; sacc+=A0; sacc+=A1; sacc+=A2; sacc+=A3; PIN(sacc); W0; W1; PIN(PW); SBAR(); }while(0)
  #define EX(v) __builtin_amdgcn_exp2f(v)
  #define GAPB(MF,X,B) do{ MF; X[B]=EX(X[B]); X[B+1]=EX(X[B+1]); X[B+2]=EX(X[B+2]); X[B+3]=EX(X[B+3]); PIN(X); SBAR(); }while(0)
  #define VRD(i) do{ vlo[i]=vtr(vp_+(((i)>>2)*4096+((i)&3)*1024)); vhi[i]=vtr(vp_+(((i)>>2)*4096+((i)&3)*1024+512)); }while(0)
  #define KRD(G,j) do{ if(G){ kload2(kf,kp0+sl_next,j); SBAR(); } }while(0)
  #define STEP(C0,C1,P0,P1,t,GK,GV,GL) do{ SBAR(); \
    const lds_cptr vp_=vp0+sl_prev; \
    C0=__builtin_amdgcn_mfma_f32_32x32x16_bf16(KBF(wb0),QF,zero16,0,0,0); C1=__builtin_amdgcn_mfma_f32_32x32x16_bf16(KBF(wb1),QF,zero16,0,0,0); SBAR(); \
    VRD(0); SBAR(); float sacc=(P0[0]+P0[1]); \
    GAPA(C0=__builtin_amdgcn_mfma_f32_32x32x16_bf16(kf[0],qr[0],C0,0,0,0), P0[2],P0[3],P0[4],P0[5],     pw0[0]=PKW(P0,0), pw0[1]=PKW(P0,2), pw0); \
    VRD(4); SBAR(); GAPA(C1=__builtin_amdgcn_mfma_f32_32x32x16_bf16(kf[1],qr[0],C1,0,0,0), P0[6],P0[7],P0[8],P0[9],     pw0[2]=PKW(P0,4), pw0[3]=PKW(P0,6), pw0); \
    VRD(1); SBAR(); GAPA(C0=__builtin_amdgcn_mfma_f32_32x32x16_bf16(kf[2],qr[1],C0,0,0,0),   P0[10],P0[11],P0[12],P0[13], pw1[0]=PKW(P0,8), pw1[1]=PKW(P0,10), pw1); \
    VRD(5); SBAR(); GAPA(C1=__builtin_amdgcn_mfma_f32_32x32x16_bf16(kf[3],qr[1],C1,0,0,0),   P0[14],P0[15],P1[0],P1[1],   pw1[2]=PKW(P0,12),pw1[3]=PKW(P0,14), pw1); \
    VRD(2); SBAR(); GAPA(C0=__builtin_amdgcn_mfma_f32_32x32x16_bf16(kf[4],qr[2],C0,0,0,0),   P1[2],P1[3],P1[4],P1[5],     pw2[0]=PKW(P1,0), pw2[1]=PKW(P1,2), pw2); \
    VRD(6); SBAR(); GAPA(C1=__builtin_amdgcn_mfma_f32_32x32x16_bf16(kf[5],qr[2],C1,0,0,0),   P1[6],P1[7],P1[8],P1[9],     pw2[2]=PKW(P1,4), pw2[3]=PKW(P1,6), pw2); \
    VRD(3); SBAR(); GAPA(C0=__builtin_amdgcn_mfma_f32_32x32x16_bf16(kf[6],qr[3],C0,0,0,0),   P1[10],P1[11],P1[12],P1[13], pw3[0]=PKW(P1,8), pw3[1]=PKW(P1,10), pw3); \
    VRD(7); SBAR(); GAPA(C1=__builtin_amdgcn_mfma_f32_32x32x16_bf16(kf[7],qr[3],C1,0,0,0),   P1[14],P1[15],0.f,0.f,       pw3[2]=PKW(P1,12),pw3[3]=PKW(P1,14), pw3); \
    l_reg+=sacc; \
    if(GK){DMA_K((t)+3,sl_cur);} if(GV){DMA_V((t)+1,sl_next);} \
    CMASK(C0,C1,t); \
    { float a=MX3(C0[0],C0[1],C1[0]),b=MX3(C0[2],C0[3],C1[1]); a=MX3(a,C1[2],C1[3]); \
      _Pragma("unroll") for(int r=4;r<16;r+=4){a=MX3(a,C0[r],C0[r+1]);b=MX3(b,C0[r+2],C0[r+3]);a=MX3(a,C1[r],C1[r+1]);b=MX3(b,C1[r+2],C1[r+3]);} \
      float rm=__builtin_fmaxf(a,b); { auto rr=__builtin_amdgcn_permlane32_swap(__float_as_uint(rm),__float_as_uint(rm),false,false); rm=__builtin_fmaxf(__uint_as_float(rr[0]),__uint_as_float(rr[1])); } \
      resc=false; \
      if(__builtin_expect(__any(rm>(float)THRL),0)){ const float dl=__builtin_fmaxf(rm,0.f); mhat+=dl; \
        _Pragma("unroll") for(int r=0;r<16;++r){C0[r]-=dl;C1[r]-=dl;} \
        SETQF(); \
        const float f=__builtin_amdgcn_exp2f(-dl); l_reg*=f; if(hi==0)wsf[r32]=f; resc=true; } } \
    SBAR(); \
    GAPB(o[0]=__builtin_amdgcn_mfma_f32_32x32x16_bf16(PAF(0),VFR(0),o[0],0,0,0), C0,0); \
    GAPB(o[1]=__builtin_amdgcn_mfma_f32_32x32x16_bf16(PAF(0),VFR(4),o[1],0,0,0), C0,4); \
    KRD(GL,0); GAPB(o[0]=__builtin_amdgcn_mfma_f32_32x32x16_bf16(PAF(1),VFR(1),o[0],0,0,0), C0,8); \
    KRD(GL,1); GAPB(o[1]=__builtin_amdgcn_mfma_f32_32x32x16_bf16(PAF(1),VFR(5),o[1],0,0,0), C0,12); \
    KRD(GL,2); GAPB(o[0]=__builtin_amdgcn_mfma_f32_32x32x16_bf16(PAF(2),VFR(2),o[0],0,0,0), C1,0); \
    KRD(GL,3); GAPB(o[1]=__builtin_amdgcn_mfma_f32_32x32x16_bf16(PAF(2),VFR(6),o[1],0,0,0), C1,4); \
    GAPB(o[0]=__builtin_amdgcn_mfma_f32_32x32x16_bf16(PAF(3),VFR(3),o[0],0,0,0), C1,8); \
    GAPB(o[1]=__builtin_amdgcn_mfma_f32_32x32x16_bf16(PAF(3),VFR(7),o[1],0,0,0), C1,12); \
    if(GL){ LOADB((t)+1); } \
    }while(0)
  int t=1;
  #undef CMASK
  #define CMASK(P0,P1,t) do{ if constexpr(MODE==1){const int dq_=cw-(t0+(t)); if(dq_>=0&&dq_<=2)cbias(P0,P1,dq_,qloc,hi,RBt);} }while(0)
  for(;t+5<NT;t+=2){
    STEP(pB0,pB1,pA0,pA1,t,true,true,true);     WAIT_BAR(2); RESC(); ROT();
    STEP(pA0,pA1,pB0,pB1,t+1,true,true,true);   WAIT_BAR(2); RESC(); ROT();
  }
  #undef CMASK
  #define CMASK(P0,P1,t) do{ if constexpr(MODE==0){int jb_=(t)-(NT-4); if(jb_>=0)cmask(P0,P1,jb_,qrel,hi);} else {const int dq_=cw-(t0+(t)); if(dq_>=0&&dq_<=2)cbias(P0,P1,dq_,qloc,hi,RBt);} }while(0)
  #define ENDW(tt) do{ if((tt)+3<NT){WAIT_BAR(2);} else if((tt)+2<NT){WAIT_BAR(1);} else {WAIT_BAR(0);} }while(0)
  for(;t+1<NT;t+=2){
    STEP(pB0,pB1,pA0,pA1,t,(t+3<NT),(t+1<NT),(t+1<NT));       ENDW(t);   RESC(); ROT();
    STEP(pA0,pA1,pB0,pB1,t+1,(t+4<NT),(t+2<NT),(t+2<NT));     ENDW(t+1); RESC(); ROT();
  }
  STEP(pB0,pB1,pA0,pA1,NT-1,false,false,false); RESC();
  { float sacc=pB0[0]+pB0[1]; _Pragma("unroll") for(int r=2;r<16;++r)sacc+=pB0[r]; _Pragma("unroll") for(int r=0;r<16;++r)sacc+=pB1[r]; l_reg+=sacc;
    pw0=(u32x4){PKW(pB0,0),PKW(pB0,2),PKW(pB0,4),PKW(pB0,6)};pw1=(u32x4){PKW(pB0,8),PKW(pB0,10),PKW(pB0,12),PKW(pB0,14)};pw2=(u32x4){PKW(pB1,0),PKW(pB1,2),PKW(pB1,4),PKW(pB1,6)};pw3=(u32x4){PKW(pB1,8),PKW(pB1,10),PKW(pB1,12),PKW(pB1,14)};
    SBAR(); pv(o,vb0+sl_cur,PAF(0),PAF(1),PAF(2),PAF(3)); }
  #undef PKW
  #undef PAF
  #undef VFR
  #undef PIN
  #undef MX3
  #undef GAPA
  #undef GAPB
  #undef EX
  #undef VRD
  #undef KRD
  #undef STEP
  #undef ENDW
  { float la_=l_reg, lb_=l_reg; asm volatile("s_nop 1\n\tv_permlane32_swap_b32_e32 %0, %1\n\ts_nop 1":"+v"(la_),"+v"(lb_)); l_reg=la_+lb_; }
  if(hi==0)wsf[32+r32]=l_reg;asm volatile("s_waitcnt lgkmcnt(0)":::"memory");
  float rli[16];
  #pragma unroll
  for(int r=0;r<16;++r)rli[r]=__builtin_amdgcn_rcpf(__builtin_fmaxf(wsf[32+crow(r,hi)],1.0e-37f));
  bf16*Ow=O+(rowbase+q0+wid*QBLK)*PO+h*D;
  { bf16*stg=(bf16*)(shm+LDS_OST)+wid*2048;
    #pragma unroll
    for(int r=0;r<16;++r){const int orow=crow(r,hi);
      #pragma unroll
      for(int d0=0;d0<2;++d0)stg[orow*64+d0*32+r32]=__float2bfloat16(o[d0][r]*rli[r]);}
    asm volatile("s_waitcnt lgkmcnt(0)":::"memory");
    #pragma unroll
    for(int i=0;i<4;++i){const int row=i*8+(lane>>3),ch=lane&7; const u32x4 v=*(const u32x4*)(stg+row*64+ch*8); ATTN_STORE16(Ow+(long)row*PO+ch*8,v);
      float q_=0.f;
      #pragma unroll
      for(int e_=0;e_<4;++e_){const float lo_=__builtin_bit_cast(float,v[e_]<<16),hi_=__builtin_bit_cast(float,v[e_]&0xffff0000u); q_+=lo_*lo_+hi_*hi_;}
      q_+=swzx<1>(q_); q_+=swzx<2>(q_); q_+=swzx<4>(q_);
      if(ch==0)__hip_atomic_fetch_add(stat+((rowbase+q0+wid*QBLK+row)*2+MODE),q_,__ATOMIC_RELAXED,__HIP_MEMORY_SCOPE_AGENT);} }
  asm volatile("s_waitcnt lgkmcnt(0)\n\ts_barrier":::"memory");
  #undef DMA_K
  #undef KBF
  #undef wb0
  #undef wb1
  #undef QF
  #undef SETQF
  #undef LOADB
  #undef DMA_V
  #undef CMASK
  #undef START
  #undef RESC
  #undef ROT
}
constexpr int ATTN_LDS_BYTES=LDS_BYTES;
#undef SBAR
#undef WAIT_BAR
}

#define LAS __attribute__((address_space(3)))
#ifndef DBG_OFF
#define DBG_OFF 0
#endif
#ifndef PROBE_X2
#define PROBE_X2 0
#endif
typedef unsigned short u16;
typedef float f32x4 __attribute__((ext_vector_type(4)));
typedef unsigned v4u __attribute__((ext_vector_type(4)));
typedef unsigned v2u __attribute__((ext_vector_type(2)));

constexpr int T = 32768, DMODEL = 1024, SEQ = 16384, NLAYER = 2, DFF = 2816, INC = 3080, NMEM = 256;
constexpr float EPS = 1e-6f, LOG2E = 1.4426950408889634f;
constexpr float C2 = 0.125f * LOG2E;
constexpr float CM = 0.0625f * LOG2E;
constexpr size_t MiB = 1u << 20;
constexpr size_t WT_LAYER = 33 * MiB, W_QKV = 0, W_OUT = 6 * MiB, W_MQ = 8 * MiB, W_MKV = 10 * MiB, W_MO = 14 * MiB, W_GU = 16 * MiB, W_D = 27 * MiB;
constexpr size_t OFF_WT = 0, OFF_XB = 66 * MiB, OFF_OB = 130 * MiB, OFF_Y = 194 * MiB, OFF_QKV = 258 * MiB, OFF_QM = OFF_QKV, OFF_PM = OFF_QKV + 64 * MiB, OFF_HF = OFF_QKV;
constexpr size_t OFF_LF = 450 * MiB, OFF_CS = 451 * MiB, OFF_MN = 452 * MiB, OFF_KM = 453 * MiB, OFF_VM = 455 * MiB, OFF_CTL = 457 * MiB, OFF_STAT = OFF_CTL + 65536, CTL_BYTES = 65536 + 2 * 32768 * 2 * 4  , OFF_WQK = 458 * MiB, OFF_VWO = 466 * MiB, WS_END = 474 * MiB;
constexpr int LDS_BYTES = 155648;
constexpr int LDS_X_OFF = 131072;
constexpr int LDS_MISC_OFF = 149504;
static_assert(attn_body::ATTN_LDS_BYTES <= LDS_MISC_OFF && LDS_MISC_OFF + 16 <= LDS_BYTES && LDS_X_OFF + 8192 <= LDS_BYTES && pg8::STAGE_BYTES <= LDS_X_OFF, "LDS map");

__device__ __forceinline__ float wave_sum(float v) {
    v += pg8::swz_xor<1>(v); v += pg8::swz_xor<2>(v); v += pg8::swz_xor<4>(v); v += pg8::swz_xor<8>(v); v += pg8::swz_xor<16>(v);
    return pg8::half_sum(v);
}
__device__ __forceinline__ float log1p_exp_neg(float a) {
    const float t = __builtin_amdgcn_exp2f(-a * 1.4426950408889634f);
    const float ser = t * (1.0f + t * (-0.5f + t * (0.33333334f + t * (-0.25f + t * (0.2f + t * -0.16666667f)))));
    return t < 0.125f ? ser : __builtin_amdgcn_logf(1.0f + t) * 0.69314718056f;
}
__device__ __forceinline__ unsigned f2bf(float f) { unsigned u = __builtin_bit_cast(unsigned, f); return (u + 0x7fffu + ((u >> 16) & 1u)) >> 16; }
__device__ __forceinline__ unsigned pk2(float lo, float hi) { return f2bf(lo) | (f2bf(hi) << 16); }
__device__ __forceinline__ float bflo(unsigned w) { return __builtin_bit_cast(float, w << 16); }
__device__ __forceinline__ float bfhi(unsigned w) { return __builtin_bit_cast(float, w & 0xffff0000u); }

__device__ __forceinline__ void wt_item(const float* W, int K, int Nsrc, u16* WT, int drow, int scol, int k0, const float* gain, const float* gain2, float scale, LAS float* scr, int lane) {
    f32x4 v[8];
#pragma unroll
    for (int i = 0; i < 8; ++i) { const int kk = 8 * i + (lane >> 3); v[i] = *(const f32x4*)(W + (size_t)(k0 + kk) * Nsrc + scol + 4 * (lane & 7)); }
#pragma unroll
    for (int i = 0; i < 8; ++i) { const int kk = 8 * i + (lane >> 3), k = k0 + kk; float gsc = scale;
        if (gain) gsc *= (gain2 && k >= 512) ? gain2[k - 512] : gain[k];
        LAS float* d = scr + kk * 33 + 4 * (lane & 7); d[0] = v[i][0] * gsc; d[1] = v[i][1] * gsc; d[2] = v[i][2] * gsc; d[3] = v[i][3] * gsc; }
    asm volatile("s_waitcnt lgkmcnt(0)" ::: "memory");
    const int c = lane & 7;
#pragma unroll
    for (int j = 0; j < 4; ++j) { const int n = (lane >> 3) + 8 * j; const LAS float* s = scr + (8 * c) * 33 + n;
        v4u o; o.x = pk2(s[0 * 33], s[1 * 33]); o.y = pk2(s[2 * 33], s[3 * 33]); o.z = pk2(s[4 * 33], s[5 * 33]); o.w = pk2(s[6 * 33], s[7 * 33]);
        *(v4u*)(WT + (size_t)(drow + n) * K + k0 + 8 * c) = o; }
    asm volatile("s_waitcnt lgkmcnt(0)" ::: "memory");
}

template <bool HAS_Y>
__device__ __forceinline__ void rownorm_phase(const float* xin, const u16* Y, const float* gpost, float* xout, u16* XBo, bool write_xb, bool gates,
                                              const float* wsrc, const float* gpre, const float* bfg, float* LF, LAS float* WG, int gw, int NGW, int tid_, int lane_) {
    asm volatile("" : "+v"(tid_)); const int tid = tid_, lane = tid_ & 63; (void)lane_;
    if (gates) {
        float gq[16], wq[16];
#pragma unroll
        for (int i = 0; i < 16; ++i) { const int e = tid + 512 * i, c = e >> 3, h = e & 7; gq[i] = gpre[c]; wq[i] = wsrc[(size_t)c * INC + 1536 + h]; }
#pragma unroll
        for (int i = 0; i < 16; ++i) { const int e = tid + 512 * i, c = e >> 3, h = e & 7;
            WG[(((c >> 8) * 4 + (c & 3)) * 2 + (h >> 2)) * 256 + ((c & 255) >> 2) * 4 + (h & 3)] = gq[i] * wq[i]; }
        __syncthreads();
    }
    f32x4 gv[4];
#pragma unroll
    for (int j = 0; j < 4; ++j) gv[j] = HAS_Y ? *(const f32x4*)(gpost + 256 * j + 4 * lane) : (f32x4){0.f, 0.f, 0.f, 0.f};
    for (int m0 = gw; m0 < T; m0 += 2 * NGW) {
        f32x4 xv[2][4], yf[2][4]; float ry[2], r[2];
#pragma unroll
        for (int u = 0; u < 2; ++u) { const int m = m0 + u * NGW;
#pragma unroll
            for (int j = 0; j < 4; ++j) xv[u][j] = *(const f32x4*)(xin + (size_t)m * DMODEL + 256 * j + 4 * lane);
            if (HAS_Y) {
#pragma unroll
                for (int j = 0; j < 4; ++j) { const v2u w = *(const v2u*)(Y + (size_t)m * DMODEL + 256 * j + 4 * lane); yf[u][j] = (f32x4){bflo(w.x), bfhi(w.x), bflo(w.y), bfhi(w.y)}; }
            }
        }
#pragma unroll
        for (int u = 0; u < 2; ++u) { const int m = m0 + u * NGW;
            if (HAS_Y) {
                float sy = 0.f;
#pragma unroll
                for (int j = 0; j < 4; ++j) sy += (yf[u][j][0] * yf[u][j][0] + yf[u][j][1] * yf[u][j][1]) + (yf[u][j][2] * yf[u][j][2] + yf[u][j][3] * yf[u][j][3]);
                sy = wave_sum(sy); ry[u] = 1.0f / sqrtf(sy * (1.0f / DMODEL) + EPS);
#pragma unroll
                for (int j = 0; j < 4; ++j) { xv[u][j] = xv[u][j] + yf[u][j] * ry[u] * gv[j]; *(f32x4*)(xout + (size_t)m * DMODEL + 256 * j + 4 * lane) = xv[u][j]; }
            }
            float sx = 0.f;
#pragma unroll
            for (int j = 0; j < 4; ++j) sx += (xv[u][j][0] * xv[u][j][0] + xv[u][j][1] * xv[u][j][1]) + (xv[u][j][2] * xv[u][j][2] + xv[u][j][3] * xv[u][j][3]);
            sx = wave_sum(sx); r[u] = 1.0f / sqrtf(sx * (1.0f / DMODEL) + EPS);
            if (write_xb) {
#pragma unroll
                for (int j = 0; j < 4; ++j) { v2u o; o.x = pk2(xv[u][j][0] * r[u], xv[u][j][1] * r[u]); o.y = pk2(xv[u][j][2] * r[u], xv[u][j][3] * r[u]); *(v2u*)(XBo + (size_t)m * DMODEL + 256 * j + 4 * lane) = o; }
            }
            if (gates) {
                float a0 = 0.f, a1 = 0.f, a2 = 0.f, a3 = 0.f, a4 = 0.f, a5 = 0.f, a6 = 0.f, a7 = 0.f;
#pragma unroll
                for (int j = 0; j < 4; ++j)
#pragma unroll
                    for (int i = 0; i < 4; ++i) { const float xn = xv[u][j][i] * r[u];
                        const f32x4 w0 = *(const LAS f32x4*)(WG + ((j * 4 + i) * 2 + 0) * 256 + lane * 4), w1 = *(const LAS f32x4*)(WG + ((j * 4 + i) * 2 + 1) * 256 + lane * 4);
                        a0 += xn * w0[0]; a1 += xn * w0[1]; a2 += xn * w0[2]; a3 += xn * w0[3]; a4 += xn * w1[0]; a5 += xn * w1[1]; a6 += xn * w1[2]; a7 += xn * w1[3]; }
                a0 = wave_sum(a0); a1 = wave_sum(a1); a2 = wave_sum(a2); a3 = wave_sum(a3); a4 = wave_sum(a4); a5 = wave_sum(a5); a6 = wave_sum(a6); a7 = wave_sum(a7);
                float z = a0; z = lane == 1 ? a1 : z; z = lane == 2 ? a2 : z; z = lane == 3 ? a3 : z; z = lane == 4 ? a4 : z; z = lane == 5 ? a5 : z; z = lane == 6 ? a6 : z; z = lane == 7 ? a7 : z;
                if (lane < 8) { z += bfg[lane]; LF[((size_t)(m / SEQ) * 8 + lane) * SEQ + (m % SEQ)] = fminf(z, 0.f) - log1p_exp_neg(fabsf(z)); }
            }
        }
    }
    __syncthreads();
}

#define XB_TMO      128
#define XB_XCNT(j)  (256  + 64 * (j))
#define XB_XSUB(j)  (1280 + 64 * (j))
#define XB_XGEN(j)  (2304 + 64 * (j))
#define XB_TOP      3328
#define XB_TOPGEN   3392
#define XCD_BAR_WORDS 3456
#define XB_SPIN_CAP (1u << 18)

__device__ __forceinline__ unsigned xb_ld(unsigned* p)              { return __hip_atomic_load(p, __ATOMIC_RELAXED, __HIP_MEMORY_SCOPE_AGENT); }
__device__ __forceinline__ unsigned xb_add(unsigned* p, unsigned v) { return __hip_atomic_fetch_add(p, v, __ATOMIC_RELAXED, __HIP_MEMORY_SCOPE_AGENT); }
__device__ __forceinline__ unsigned xb_xcc_id() { return (unsigned)__builtin_amdgcn_s_getreg((3 << 11) | 20) & 0xFu; }
#define XB_SPIN(cond, bar) do { unsigned _sp = 0; while (cond) { __builtin_amdgcn_s_sleep(1); \
    if ((++_sp & 255u) == 0u) { if (xb_ld(&(bar)[XB_TMO])) break; if (_sp > XB_SPIN_CAP) { atomicAdd(&(bar)[XB_TMO], 1u); break; } } } } while (0)

struct XcdBarrier {
    unsigned* bar; unsigned x;
    volatile LAS unsigned* st;
};

__device__ __forceinline__ XcdBarrier xcd_barrier_post(unsigned* bar, volatile LAS unsigned* st) {
    XcdBarrier b; b.bar = bar; b.x = xb_xcc_id(); b.st = st;
    if (threadIdx.x == 0) (void)xb_add(&bar[XB_XCNT(b.x)], 1u);
    return b;
}
__device__ __forceinline__ void xcd_barrier_complete(unsigned* bar, unsigned x, unsigned& nloc, unsigned& nx) {
    const unsigned G = gridDim.x * gridDim.y * gridDim.z;
    unsigned sum, cnt, mine, sp = 0u;
    for (;;) {
        sum = 0u; cnt = 0u; mine = 0u;
#pragma unroll
        for (unsigned j = 0; j < 16; ++j) { const unsigned c = xb_ld(&bar[XB_XCNT(j)]); sum += c; cnt += (c > 0u) ? 1u : 0u; mine = (j == x) ? c : mine; }
        if (sum == G) break;
        __builtin_amdgcn_s_sleep(1);
        if ((++sp & 255u) == 0u) { if (xb_ld(&bar[XB_TMO])) break; if (sp > XB_SPIN_CAP) { atomicAdd(&bar[XB_TMO], 1u); break; } }
    }
    nloc = mine > 0u ? mine : 1u; nx = cnt > 0u ? cnt : 1u;
}

__device__ __forceinline__ void xcd_barrier(const XcdBarrier& b) {
    asm volatile("s_waitcnt vmcnt(0)" ::: "memory");
    __syncthreads();
    if (threadIdx.x == 0) {
        unsigned* bar = b.bar;
        __builtin_amdgcn_s_waitcnt(0);
        unsigned nloc = b.st[0], nx = b.st[1];
        if (nloc == 0u) { xcd_barrier_complete(bar, b.x, nloc, nx); b.st[0] = nloc; b.st[1] = nx; }
        const unsigned old = xb_add(&bar[XB_XSUB(b.x)], 1u);
        const unsigned gen = old / nloc;
        if (old + 1u == (gen + 1u) * nloc) {
            __builtin_amdgcn_fence(__ATOMIC_RELEASE, "agent");
            asm volatile("s_waitcnt vmcnt(0)" ::: "memory");
            const unsigned og = xb_add(&bar[XB_TOP], 1u);
            const unsigned tg = og / nx;
            if (og + 1u == (tg + 1u) * nx) xb_add(&bar[XB_TOPGEN], 1u);
            else XB_SPIN(xb_ld(&bar[XB_TOPGEN]) == tg, bar);
            __builtin_amdgcn_fence(__ATOMIC_ACQUIRE, "agent");
            asm volatile("s_waitcnt vmcnt(0)" ::: "memory");
        } else {
            XB_SPIN(xb_ld(&bar[XB_TOPGEN]) == gen, bar);
            __builtin_amdgcn_fence(__ATOMIC_ACQUIRE, "agent");
            asm volatile("s_waitcnt vmcnt(0)" ::: "memory");
        }
    }
    __syncthreads();
}

struct Params { const float* in[20]; float* out; unsigned char* ws; };

__global__ void __launch_bounds__(512, 2) fwd_kernel(Params p) {
    extern __shared__ __attribute__((aligned(16))) unsigned char lds[];
    cg::grid_group grid = cg::this_grid();
    LAS unsigned char* ldsL = (LAS unsigned char*)lds;
#define PHASE_IDS int tid_ = threadIdx.x; asm volatile("" : "+v"(tid_)); const int tid = tid_, lane = tid_ & 63, wave = __builtin_amdgcn_readfirstlane(tid_ >> 6), gw = vcu * 8 + wave; (void)tid; (void)lane; (void)gw;
    const int G = gridDim.x, bx = blockIdx.x;
    const int vcu = (G % 8 == 0) ? (bx % 8) * (G / 8) + bx / 8 : bx;
    const int NGW = G * 8;
    unsigned char* ws = p.ws;
    volatile LAS unsigned* MISC = (volatile LAS unsigned*)(ldsL + LDS_MISC_OFF);
    if (threadIdx.x < 4) MISC[threadIdx.x] = 0u;
    __syncthreads();
    XcdBarrier bar = xcd_barrier_post((unsigned*)(ws + OFF_CTL), MISC);
    const float* x_in = p.in[0]; const float* mem = p.in[1]; const float* g_mix_pre = p.in[2]; const float* w_in = p.in[3]; const float* b_fgate = p.in[4];
    const float* rel_bias = p.in[5]; const float* g_fox_out = p.in[6]; const float* g_chunk_out = p.in[7]; const float* w_out = p.in[8]; const float* g_mix_post = p.in[9];
    const float* g_mem_pre = p.in[10]; const float* g_mem_kv = p.in[11]; const float* w_mem_q = p.in[12]; const float* w_mem_kv = p.in[13]; const float* w_mem_o = p.in[14];
    const float* g_mem_post = p.in[15]; const float* g_ffn_pre = p.in[16]; const float* w_gate_up = p.in[17]; const float* w_down = p.in[18]; const float* g_ffn_post = p.in[19];
    u16* XB = (u16*)(ws + OFF_XB); u16* OB = (u16*)(ws + OFF_OB); u16* Yb = (u16*)(ws + OFF_Y); u16* QKV = (u16*)(ws + OFF_QKV);
    u16* PM = (u16*)(ws + OFF_PM); u16* HF = (u16*)(ws + OFF_HF); float* LF = (float*)(ws + OFF_LF); float* CS = (float*)(ws + OFF_CS); u16* MN = (u16*)(ws + OFF_MN);

    for (int rp_ = 0; rp_ < ((PROBE_X2 & 64) ? 2 : 1); ++rp_)
    if (!(DBG_OFF & 32)) {
        PHASE_IDS
        LAS float* scr = (LAS float*)(ldsL + wave * 16384);
        constexpr int I_QKV = 16 * 96, I_OUT = 16 * 32, I_MQ = 16 * 32, I_MKV = 16 * 64, I_MO = 16 * 32, I_GU = 16 * 176, I_D = 44 * 32, I_LAYER = I_QKV + I_OUT + I_MQ + I_MKV + I_MO + I_GU + I_D;
        for (int it = gw; it < NLAYER * I_LAYER; it += NGW) {
            const int l = it / I_LAYER; int r = it % I_LAYER; unsigned char* wl = ws + OFF_WT + (size_t)l * WT_LAYER;
            if (r < I_QKV) { const int kb = r / 96, n = 32 * (r % 96); const float sc = (n < 512 || (n >= 1536 && n < 2048)) ? C2 : 1.0f;
                wt_item(w_in + (size_t)l * DMODEL * INC, DMODEL, INC, (u16*)(wl + W_QKV), n, n < 1536 ? n : n + 8, 64 * kb, g_mix_pre + l * DMODEL, nullptr, sc, scr, lane); continue; } r -= I_QKV;
            if (r < I_OUT) { const int kb = r / 32, n = 32 * (r % 32);
                wt_item(w_out + (size_t)l * DMODEL * DMODEL, DMODEL, DMODEL, (u16*)(wl + W_OUT), n, n, 64 * kb, g_fox_out + l * 512, g_chunk_out + l * 512, 1.0f, scr, lane); continue; } r -= I_OUT;
            if (r < I_MQ) {
#pragma unroll
                for (int rr = 0; rr < 2; ++rr) { const int k = 2 * r + rr; const float gsc = g_mem_pre[l * DMODEL + k] * CM; const float* src = w_mem_q + ((size_t)l * DMODEL + k) * DMODEL; u16* dst = (u16*)(wl + W_MQ) + (size_t)k * DMODEL;
#pragma unroll
                    for (int j = 0; j < 4; ++j) { const f32x4 v = *(const f32x4*)(src + 256 * j + 4 * lane); v2u o; o.x = pk2(v[0] * gsc, v[1] * gsc); o.y = pk2(v[2] * gsc, v[3] * gsc); *(v2u*)(dst + 256 * j + 4 * lane) = o; } }
                continue; } r -= I_MQ;
            if (r < I_MKV) { const int kb = r / 64, n = 32 * (r % 64);
                wt_item(w_mem_kv + (size_t)l * DMODEL * 2 * DMODEL, DMODEL, 2 * DMODEL, (u16*)(wl + W_MKV), n, n, 64 * kb, g_mem_kv + l * DMODEL, nullptr, 1.0f, scr, lane); continue; } r -= I_MKV;
            if (r < I_MO) { const int kb = r / 32, n = 32 * (r % 32);
                wt_item(w_mem_o + (size_t)l * DMODEL * DMODEL, DMODEL, DMODEL, (u16*)(wl + W_MO), n, n, 64 * kb, nullptr, nullptr, 1.0f, scr, lane); continue; } r -= I_MO;
            if (r < I_GU) { const int kb = r / 176, n = 32 * (r % 176); const int scol = ((n >> 7) & 1) * DFF + 128 * (n >> 8) + (n & 127);
                wt_item(w_gate_up + (size_t)l * DMODEL * 2 * DFF, DMODEL, 2 * DFF, (u16*)(wl + W_GU), n, scol, 64 * kb, g_ffn_pre + l * DMODEL, nullptr, 1.0f, scr, lane); continue; } r -= I_GU;
            { const int kb = r / 32, n = 32 * (r % 32);
                wt_item(w_down + (size_t)l * DFF * DMODEL, DFF, DMODEL, (u16*)(wl + W_D), n, n, 64 * kb, nullptr, nullptr, 1.0f, scr, lane); }
        }
        for (int m = gw; m < 2 * NMEM; m += NGW) {
            f32x4 v[4]; float s = 0.f;
#pragma unroll
            for (int j = 0; j < 4; ++j) { v[j] = *(const f32x4*)(mem + (size_t)m * DMODEL + 256 * j + 4 * lane); s += (v[j][0] * v[j][0] + v[j][1] * v[j][1]) + (v[j][2] * v[j][2] + v[j][3] * v[j][3]); }
            s = wave_sum(s); const float r = 1.0f / sqrtf(s * (1.0f / DMODEL) + EPS);
#pragma unroll
            for (int j = 0; j < 4; ++j) { v2u o; o.x = pk2(v[j][0] * r, v[j][1] * r); o.y = pk2(v[j][2] * r, v[j][3] * r); *(v2u*)(MN + (size_t)m * DMODEL + 256 * j + 4 * lane) = o; }
        }
        __syncthreads();
        rownorm_phase<false>(x_in, nullptr, nullptr, nullptr, XB, true, true, w_in, g_mix_pre, b_fgate, LF, (LAS float*)ldsL, gw, NGW, tid, lane);
    }
    xcd_barrier(bar);
    if (ws == nullptr) grid.sync();

    for (int step = 0; step < 22; ++step) {
        const int l = step / 11, st = step % 11;
        if (st == 2) continue;
        float* STAT = (float*)(ws + OFF_STAT) + (size_t)l * T * 2;
        unsigned char* wl = ws + OFF_WT + (size_t)l * WT_LAYER;
        if (st == 1) {
            const attn_body::bf16* Qb = (const attn_body::bf16*)QKV; attn_body::bf16* Ob = (attn_body::bf16*)OB;
            for (int rp_ = 0; rp_ < ((PROBE_X2 & 1) ? 2 : 1); ++rp_)
            for (int w = vcu; w < 1024; w += G) { const int i = w >> 8, vv = w & 255, bh = vv >> 4, s = vv & 15; const int qb = (i == 0) ? s : (i == 1) ? 31 - s : (i == 2) ? 32 + s : 63 - s;
                if (!(DBG_OFF & 1)) attn_body::attn_unit<0, 64>(bh >> 3, bh & 7, qb, Qb, Qb + 512, Qb + 1024, Ob, (char*)lds, CS + (size_t)bh * SEQ, STAT); }
            for (int rp_ = 0; rp_ < ((PROBE_X2 & 2) ? 2 : 1); ++rp_)
            for (int w = vcu; w < 1024; w += G) { const int i = w >> 8, vv = w & 255, bh = vv >> 4, s = vv & 15; const int qb = 16 * i + s;
                if (!(DBG_OFF & 2)) attn_body::attn_unit<1, 64>(bh >> 3, bh & 7, qb, Qb + 1536, Qb + 2048, Qb + 2560, Ob + 512, (char*)lds, rel_bias + (size_t)(l * 8 + (bh & 7)) * 192, STAT); }
        } else if (st == 2) {
            PHASE_IDS
            if (!(DBG_OFF & 128)) for (int m = gw; m < T; m += NGW) {
                v2u w[4]; float sf = 0.f, sc = 0.f; f32x4 v[4];
#pragma unroll
                for (int j = 0; j < 4; ++j) { w[j] = *(const v2u*)(OB + (size_t)m * DMODEL + 256 * j + 4 * lane); v[j] = (f32x4){bflo(w[j].x), bfhi(w[j].x), bflo(w[j].y), bfhi(w[j].y)};
                    const float q = (v[j][0] * v[j][0] + v[j][1] * v[j][1]) + (v[j][2] * v[j][2] + v[j][3] * v[j][3]); if (j < 2) sf += q; else sc += q; }
                sf = wave_sum(sf); sc = wave_sum(sc);
                const float rf = 1.0f / sqrtf(sf * (1.0f / 512.0f) + EPS), rc = 1.0f / sqrtf(sc * (1.0f / 512.0f) + EPS);
#pragma unroll
                for (int j = 0; j < 4; ++j) { const float r = j < 2 ? rf : rc; v2u o; o.x = pk2(v[j][0] * r, v[j][1] * r); o.y = pk2(v[j][2] * r, v[j][3] * r); *(v2u*)(OB + (size_t)m * DMODEL + 256 * j + 4 * lane) = o; }
            }
        } else if (st == 4 || st == 7 || st == 10) {
            const float* gp = (st == 4 ? g_mix_post : st == 7 ? g_mem_post : g_ffn_post) + l * DMODEL;
            const float* xi = (l == 0 && st == 4) ? x_in : p.out;
            const bool gates = (st == 10 && l == 0), wxb = !(st == 10 && l == 1);
            PHASE_IDS
            if (PROBE_X2 & 32) rownorm_phase<true>(xi, Yb, gp, (float*)(ws + OFF_QKV), (u16*)(ws + OFF_QKV + 128 * MiB), true, false, w_in + (size_t)DMODEL * INC, g_mix_pre + DMODEL, b_fgate + 8, LF, (LAS float*)ldsL, gw, NGW, tid, lane);
            if (!(DBG_OFF & 64)) rownorm_phase<true>(xi, Yb, gp, p.out, XB, wxb, gates, w_in + (size_t)DMODEL * INC, g_mix_pre + DMODEL, b_fgate + 8, LF, (LAS float*)ldsL, gw, NGW, tid, lane);
        } else if (st == 5) {
            pg8::Gemm g{XB, (const u16*)(ws + OFF_WQK + (size_t)l * 4 * MiB), DMODEL, DMODEL, DMODEL}; pg8::Order S; S.init(T / 256, 4, G, bx, (size_t)256 * DMODEL, 0, (size_t)256 * DMODEL, (size_t)DMODEL * DMODEL, SEQ / 256);
            pg8::EpiSoftmax E{PM, DMODEL, (LAS float*)(ldsL + LDS_X_OFF)};
            for (int rp_ = 0; rp_ < ((PROBE_X2 & 16) ? 2 : 1); ++rp_)
            if (!(DBG_OFF & 4)) pg8::gemm_phase<pg8::EpiSoftmax, pg8::Order, true, true>(ldsL, g, S, E);
        } else if (st == 8) {
            pg8::Gemm g{XB, (const u16*)(wl + W_GU), DMODEL, DMODEL, DMODEL}; pg8::Order S; S.init(T / 256, 2 * DFF / 256, G, bx, (size_t)256 * DMODEL, 0, (size_t)256 * DMODEL, 0, 1);
            pg8::EpiSwiglu E{HF, DFF};
            for (int rp_ = 0; rp_ < ((PROBE_X2 & 8) ? 2 : 1); ++rp_)
            if (!(DBG_OFF & 8)) pg8::gemm_phase<pg8::EpiSwiglu, pg8::Order, true, true>(ldsL, g, S, E);
        } else {
            if (!(DBG_OFF & 256) && st == 0 && vcu < 16) {
                PHASE_IDS
                const int bh = vcu, s0 = tid * 32; const f32x4* src = (const f32x4*)(LF + (size_t)bh * SEQ + s0);
                f32x4 lv[8]; float sum = 0.f;
#pragma unroll
                for (int i = 0; i < 8; ++i) { lv[i] = src[i]; sum += (lv[i][0] + lv[i][1]) + (lv[i][2] + lv[i][3]); }
                LAS float* sh = (LAS float*)ldsL;
                sh[tid] = sum;
                __syncthreads();
                if (tid < 8) { float wt = 0.f; for (int i = 0; i < 64; ++i) wt += sh[64 * tid + i]; sh[512 + tid] = wt; }
                __syncthreads();
                float run = 0.f; for (int i = 0; i < wave; ++i) run += sh[512 + i];
                for (int i = 0; i < lane; ++i) run += sh[64 * wave + i];
                f32x4* dst = (f32x4*)(CS + (size_t)bh * SEQ + s0);
#pragma unroll
                for (int i = 0; i < 8; ++i) { f32x4 o; run += lv[i][0]; o[0] = run; run += lv[i][1]; o[1] = run; run += lv[i][2]; o[2] = run; run += lv[i][3]; o[3] = run; dst[i] = o; }
                __syncthreads();
            }
            const int njobs = (st == 0 && l == 0) ? 5 : (st == 3 && l == 0) ? 9 : 1;
            for (int j = 0; j < njobs; ++j) {
                pg8::Gemm g; pg8::Order S; pg8::EpiStore E;
                if (st == 0 && njobs == 5 && j < 4) {
                    const int ll = j >> 1; unsigned char* wll = ws + OFF_WT + (size_t)ll * WT_LAYER; const int c = (bx + G - 8 * j) % G;
                    if ((j & 1) == 0) { g = pg8::Gemm{MN, (const u16*)(wll + W_MKV), DMODEL, DMODEL, DMODEL}; S.init(2, 4, G, c, (size_t)256 * DMODEL, 0, (size_t)256 * DMODEL, 0, 1);
                        E = pg8::EpiStore{(u16*)(ws + OFF_KM + (size_t)ll * MiB), DMODEL}; }
                    else { g = pg8::Gemm{MN, (const u16*)(wll + W_MKV) + (size_t)DMODEL * DMODEL, DMODEL, DMODEL, DMODEL}; S.init(2, 4, G, c, (size_t)256 * DMODEL, 0, (size_t)256 * DMODEL, 0, 1);
                        E = pg8::EpiStore{(u16*)(ws + OFF_VM + (size_t)ll * MiB), DMODEL}; }
                } else if (st == 0) { g = pg8::Gemm{XB, (const u16*)(wl + W_QKV), DMODEL, DMODEL, DMODEL}; S.init(T / 256, 12, G, bx, (size_t)256 * DMODEL, 0, (size_t)256 * DMODEL, 0, 1); E = pg8::EpiStore{QKV, 3072}; }
                else if (st == 3 && njobs == 9 && j < 8) {
                    const int lb = j >> 1, ll = lb >> 1; unsigned char* wll = ws + OFF_WT + (size_t)ll * WT_LAYER; const int c = (bx + G - 16 * j) % G;
                    if ((j & 1) == 0) { g = pg8::Gemm{(const u16*)(ws + OFF_KM) + (size_t)lb * NMEM * DMODEL, (const u16*)(wll + W_MQ), 256, DMODEL, DMODEL}; S.init(4, 4, G, c, 256, 0, (size_t)256 * DMODEL, 256, 1);
                        E = pg8::EpiStore{(u16*)(ws + OFF_WQK) + (size_t)lb * DMODEL * DMODEL, DMODEL}; }
                    else { g = pg8::Gemm{(const u16*)(wll + W_MO), (const u16*)(ws + OFF_VM) + (size_t)lb * NMEM * DMODEL, 256, DMODEL, DMODEL}; S.init(4, 4, G, c, (size_t)256 * DMODEL, 256, 256, 0, 1);
                        E = pg8::EpiStore{(u16*)(ws + OFF_VWO) + (size_t)lb * DMODEL * DMODEL, DMODEL}; }
                }
                else if (st == 3) { g = pg8::Gemm{OB, (const u16*)(wl + W_OUT), DMODEL, DMODEL, DMODEL}; S.init(T / 256, 4, G, bx, (size_t)256 * DMODEL, 0, (size_t)256 * DMODEL, 0, 1); E = pg8::EpiStore{Yb, DMODEL, STAT}; }
                else if (st == 6) { g = pg8::Gemm{PM, (const u16*)(ws + OFF_VWO + (size_t)l * 4 * MiB), DMODEL, DMODEL, DMODEL}; S.init(T / 256, 4, G, bx, (size_t)256 * DMODEL, 0, (size_t)256 * DMODEL, (size_t)DMODEL * DMODEL, SEQ / 256); E = pg8::EpiStore{Yb, DMODEL}; }
                else { g = pg8::Gemm{HF, (const u16*)(wl + W_D), DFF, DFF, DFF}; S.init(T / 256, 4, G, bx, (size_t)256 * DFF, 0, (size_t)256 * DFF, 0, 1); E = pg8::EpiStore{Yb, DMODEL}; }
                for (int rp_ = 0; rp_ < ((PROBE_X2 & 4) ? 2 : 1); ++rp_)
                if (!(DBG_OFF & 16)) pg8::gemm_phase<pg8::EpiStore, pg8::Order, true, true>(ldsL, g, S, E);
            }
        }
        if (step != 21) xcd_barrier(bar);
#ifdef PROBE_SYNC
        xcd_barrier(bar); xcd_barrier(bar);
#endif
    }
}

extern "C" void kernel_launch(void* const* d_in, const int* in_sizes, int n_in, void* d_out, int out_size, void* d_ws, size_t ws_size, hipStream_t stream) {
    static int grid = 0;
    if (grid == 0) {
        if (n_in != 20 || in_sizes[0] != T * DMODEL || out_size != T * DMODEL || ws_size < WS_END) { fprintf(stderr, "kernel_launch: unexpected shapes (n_in %d, in0 %d, out %d, ws %zu)\n", n_in, n_in > 0 ? in_sizes[0] : -1, out_size, ws_size); grid = -1; return; }
        int dev = 0, cus = 0, per_cu = 0;
        if (hipGetDevice(&dev) != hipSuccess || hipDeviceGetAttribute(&cus, hipDeviceAttributeMultiprocessorCount, dev) != hipSuccess) { grid = -1; return; }
        if (hipFuncSetAttribute((const void*)fwd_kernel, hipFuncAttributeMaxDynamicSharedMemorySize, LDS_BYTES) != hipSuccess) { fprintf(stderr, "kernel_launch: hipFuncSetAttribute failed\n"); grid = -1; return; }
        if (hipOccupancyMaxActiveBlocksPerMultiprocessor(&per_cu, (const void*)fwd_kernel, 512, LDS_BYTES) != hipSuccess || per_cu < 1) { fprintf(stderr, "kernel_launch: occupancy query reports %d\n", per_cu); per_cu = 1; }
        (void)hipGetLastError();
        grid = cus * 1;
        while (grid > 16 && (T % (32 * grid)) != 0) --grid;
    }
    if (grid < 0) return;
    if (hipMemsetAsync((char*)d_ws + OFF_CTL, 0, CTL_BYTES, stream) != hipSuccess) { fprintf(stderr, "kernel_launch: hipMemsetAsync failed\n"); return; }
    Params p{};
    for (int i = 0; i < 20; ++i) p.in[i] = (const float*)d_in[i];
    p.out = (float*)d_out; p.ws = (unsigned char*)d_ws;
    void* args[] = {&p};
    const hipError_t e = hipLaunchCooperativeKernel((const void*)fwd_kernel, dim3(grid), dim3(512), args, LDS_BYTES, stream);
    if (e != hipSuccess) fprintf(stderr, "kernel_launch: cooperative launch failed: %s (grid %d)\n", hipGetErrorString(e), grid);
}
```
